# Optimizing an MI355X kernel written in HIP

```python
import math
import jax, jax.numpy as jnp
from jax import lax
import numpy as np

D_MODEL = 1024
BATCH = 2
SEQ = 8192
DEPTH = 2

N_A_LAYERS = DEPTH // 2
N_B_LAYERS = DEPTH - N_A_LAYERS

GDN_HEADS = 8
GDN_HEAD_DIM = 128
GDN_WIDTH = GDN_HEADS * GDN_HEAD_DIM
CONV_WIDTH = 4
CHUNK = 64
GDN_IN_COLS = 4 * GDN_WIDTH + 2 * GDN_HEADS

SB_HEADS = 8
SB_HEAD_DIM = 128
SB_WIDTH = SB_HEADS * SB_HEAD_DIM
Q_BLOCK = 128

D_FF = 4 * D_MODEL

EPS = 1e-6

kernel_name = "yoco_gdn_stickbreaking_hybrid"


def rms_norm(x, gain):
    xf = x.astype(jnp.float32)
    y = xf * lax.rsqrt(jnp.mean(xf * xf, axis=-1, keepdims=True) + EPS)
    return (y * gain.astype(jnp.float32)).astype(x.dtype)


def l2_norm(x):
    xf = x.astype(jnp.float32)
    return xf * lax.rsqrt(jnp.sum(xf * xf, axis=-1, keepdims=True) + EPS)


def causal_dwconv(x, w):
    k_w = w.shape[0]
    t_len = x.shape[1]
    xp = jnp.pad(x, ((0, 0), (k_w - 1, 0), (0, 0)))
    return sum(xp[:, i:i + t_len, :] * w[i] for i in range(k_w))


def gated_delta_rule_chunked(q, k, v, beta, g):
    b, t_len, h, dk = q.shape
    dv = v.shape[-1]
    n = t_len // CHUNK

    def chunks(t):
        t = jnp.moveaxis(t, 2, 1)
        return t.reshape((b, h, n, CHUNK) + t.shape[3:])

    q, k, v, beta, g = (chunks(t) for t in (q, k, v, beta, g))
    gc = jnp.cumsum(g, axis=-1)
    idx = jnp.arange(CHUNK)
    incl = idx[:, None] >= idx[None, :]
    strict = idx[:, None] > idx[None, :]
    diff = gc[..., :, None] - gc[..., None, :]
    decay = jnp.where(incl, jnp.exp(jnp.where(incl, diff, 0.0)), 0.0)

    kb = k * beta[..., None]
    lower = jnp.where(strict, jnp.einsum('bhnid,bhnjd->bhnij', kb, k) * decay, 0.0)
    eye = jnp.eye(CHUNK, dtype=jnp.float32)
    t_mat = lax.linalg.triangular_solve(eye + lower, jnp.broadcast_to(eye, lower.shape),
                                        left_side=True, lower=True)
    w = t_mat @ (kb * jnp.exp(gc)[..., None])
    u = t_mat @ (v * beta[..., None])
    attn = jnp.einsum('bhnid,bhnjd->bhnij', q, k) * decay
    qg = q * jnp.exp(gc)[..., None]
    kg = k * jnp.exp(gc[..., -1:] - gc)[..., None]
    g_last = jnp.exp(gc[..., -1])

    xs = tuple(jnp.moveaxis(t, 2, 0) for t in (qg, kg, w, u, attn, g_last))

    def step(state, inp):
        qg_c, kg_c, w_c, u_c, attn_c, gl_c = inp
        v_new = u_c - w_c @ state
        o_c = qg_c @ state + attn_c @ v_new
        state = state * gl_c[..., None, None] + jnp.einsum('bhck,bhcv->bhkv', kg_c, v_new)
        return state, o_c

    s0 = jnp.zeros((b, h, dk, dv), jnp.float32)
    _, o = lax.scan(step, s0, xs)
    o = jnp.moveaxis(o, 0, 2).reshape(b, h, t_len, dv)
    return jnp.moveaxis(o, 1, 2)


def gated_deltanet(h, w_in, conv_w, a_log, dt_bias, out_gain, w_out):
    b, t_len, _ = h.shape
    proj = h @ w_in
    qkv, gate, b_raw, a_raw = jnp.split(
        proj, [3 * GDN_WIDTH, 4 * GDN_WIDTH, 4 * GDN_WIDTH + GDN_HEADS], axis=-1)
    qkv = jax.nn.silu(causal_dwconv(qkv, conv_w))
    q, k, v = jnp.split(qkv, 3, axis=-1)

    def heads(t):
        return t.reshape(b, t_len, GDN_HEADS, GDN_HEAD_DIM).astype(jnp.float32)

    q = l2_norm(heads(q)) * (GDN_HEAD_DIM ** -0.5)
    k = l2_norm(heads(k))
    v = heads(v)
    beta = jax.nn.sigmoid(b_raw.astype(jnp.float32))
    g = -jnp.exp(a_log.astype(jnp.float32)) * jax.nn.softplus(
        a_raw.astype(jnp.float32) + dt_bias.astype(jnp.float32))
    o = gated_delta_rule_chunked(q, k, v, beta, g)
    o = rms_norm(o, out_gain) * jax.nn.silu(heads(gate))
    return o.reshape(b, t_len, GDN_WIDTH).astype(h.dtype) @ w_out


def stick_breaking_attention(q, k, v):
    b, h, t_len, d = q.shape
    nb = t_len // Q_BLOCK
    qb = jnp.moveaxis(q.reshape(b, h, nb, Q_BLOCK, d), 2, 0)
    key_pos = jnp.arange(t_len)
    scale = d ** -0.5

    def block(args):
        q_blk, i = args
        z = jnp.einsum('bhqd,bhkd->bhqk', q_blk, k).astype(jnp.float32) * scale
        q_pos = i * Q_BLOCK + jnp.arange(Q_BLOCK)
        before = key_pos[None, :] < q_pos[:, None]
        log_beta = jax.nn.log_sigmoid(z)
        log_1m = jnp.where(before, jax.nn.log_sigmoid(-z), 0.0)
        tail = lax.cumsum(log_1m, axis=3, reverse=True) - log_1m
        a = jnp.where(before, jnp.exp(log_beta + tail), 0.0)
        return jnp.einsum('bhqk,bhkd->bhqd', a.astype(v.dtype), v)

    o = lax.map(block, (qb, jnp.arange(nb)))
    return jnp.moveaxis(o, 0, 2).reshape(b, h, t_len, d)


def shared_kv(x, kv_gain, w_kv):
    b, t_len, _ = x.shape
    kv = rms_norm(x, kv_gain) @ w_kv
    k, v = jnp.split(kv, 2, axis=-1)
    k = k.reshape(b, t_len, SB_HEADS, SB_HEAD_DIM).transpose(0, 2, 1, 3)
    v = v.reshape(b, t_len, SB_HEADS, SB_HEAD_DIM).transpose(0, 2, 1, 3)
    return k, v


def stick_breaking_mixer(h, w_q, w_o, k_sh, v_sh):
    b, t_len, _ = h.shape
    q = (h @ w_q).reshape(b, t_len, SB_HEADS, SB_HEAD_DIM).transpose(0, 2, 1, 3)
    o = stick_breaking_attention(q, k_sh, v_sh)
    return o.transpose(0, 2, 1, 3).reshape(b, t_len, SB_WIDTH) @ w_o


def squared_relu_mlp(h, w_up, w_down):
    return jnp.square(jax.nn.relu(h @ w_up)) @ w_down


def setup_inputs(seed: int = 0) -> dict:
    key = jax.random.key(seed)
    ks = jax.random.split(key, 20)
    f32 = jnp.float32

    def nrm(k, shape, fan_in):
        return jax.random.normal(k, shape, f32) * (fan_in ** -0.5)

    def gain(k, shape):
        return 1.0 + 0.05 * jax.random.normal(k, shape, f32)

    x = jax.random.normal(ks[0], (BATCH, SEQ, D_MODEL), f32)
    dt = jnp.exp(jax.random.uniform(ks[10], (N_A_LAYERS, GDN_HEADS), f32,
                                    minval=math.log(1e-3), maxval=math.log(1e-1)))
    dt_bias = dt + jnp.log(-jnp.expm1(-dt))
    a_log = jnp.log(jax.random.uniform(ks[11], (N_A_LAYERS, GDN_HEADS), f32,
                                       minval=1.0, maxval=16.0))
    return {
        "x": x,
        "mix_pre_gain": gain(ks[1], (DEPTH, D_MODEL)),
        "mix_post_gain": gain(ks[2], (DEPTH, D_MODEL)),
        "mlp_pre_gain": gain(ks[3], (DEPTH, D_MODEL)),
        "mlp_post_gain": gain(ks[4], (DEPTH, D_MODEL)),
        "mlp_w_up": nrm(ks[5], (DEPTH, D_MODEL, D_FF), D_MODEL),
        "mlp_w_down": nrm(ks[6], (DEPTH, D_FF, D_MODEL), D_FF),
        "gdn_w_in": nrm(ks[7], (N_A_LAYERS, D_MODEL, GDN_IN_COLS), D_MODEL),
        "gdn_conv_w": nrm(ks[8], (N_A_LAYERS, CONV_WIDTH, 3 * GDN_WIDTH), CONV_WIDTH),
        "gdn_a_log": a_log,
        "gdn_dt_bias": dt_bias,
        "gdn_out_gain": gain(ks[12], (N_A_LAYERS, GDN_HEAD_DIM)),
        "gdn_w_out": nrm(ks[13], (N_A_LAYERS, GDN_WIDTH, D_MODEL), GDN_WIDTH),
        "kv_gain": gain(ks[14], (D_MODEL,)),
        "w_kv": nrm(ks[15], (D_MODEL, 2 * SB_WIDTH), D_MODEL),
        "sb_w_q": nrm(ks[16], (N_B_LAYERS, D_MODEL, SB_WIDTH), D_MODEL),
        "sb_w_o": nrm(ks[17], (N_B_LAYERS, SB_WIDTH, D_MODEL), SB_WIDTH),
    }


def reference(x, mix_pre_gain, mix_post_gain, mlp_pre_gain, mlp_post_gain, mlp_w_up, mlp_w_down,
              gdn_w_in, gdn_conv_w, gdn_a_log, gdn_dt_bias, gdn_out_gain, gdn_w_out,
              kv_gain, w_kv, sb_w_q, sb_w_o):
    k_sh = None
    v_sh = None
    for layer in range(DEPTH):
        h = rms_norm(x, mix_pre_gain[layer])
        if layer < N_A_LAYERS:
            a = layer
            mix = gated_deltanet(h, gdn_w_in[a], gdn_conv_w[a], gdn_a_log[a], gdn_dt_bias[a],
                                 gdn_out_gain[a], gdn_w_out[a])
        else:
            if layer == N_A_LAYERS:
                k_sh, v_sh = shared_kv(x, kv_gain, w_kv)
            bl = layer - N_A_LAYERS
            mix = stick_breaking_mixer(h, sb_w_q[bl], sb_w_o[bl], k_sh, v_sh)
        x = x + rms_norm(mix, mix_post_gain[layer])
        h = rms_norm(x, mlp_pre_gain[layer])
        x = x + rms_norm(squared_relu_mlp(h, mlp_w_up[layer], mlp_w_down[layer]), mlp_post_gain[layer])
    return x
```

```cpp
#include <hip/hip_runtime.h>
#include <hip/hip_cooperative_groups.h>
#include <cstdio>
namespace cg = cooperative_groups;

#define DI __device__ __forceinline__
typedef unsigned short bf16_t;
typedef short bf16x8 __attribute__((ext_vector_type(8)));
typedef float f32x4 __attribute__((ext_vector_type(4)));
typedef float f32x2 __attribute__((ext_vector_type(2)));
typedef unsigned u32x4 __attribute__((ext_vector_type(4)));
typedef unsigned u32x2 __attribute__((ext_vector_type(2)));
typedef __bf16 bf16v2 __attribute__((ext_vector_type(2)));

constexpr int T_SEQ = 8192, MTOK = 16384;
constexpr size_t MiB = (size_t)1 << 20;
constexpr int LDS_BYTES = 147456;
constexpr float EPS = 1e-6f;
#ifndef PHMASK
#define PHMASK 0xffffffffu
#endif

constexpr size_t DO_GATE = 0, DO_WTIN = 32 * MiB, DO_WTOUT0 = 41 * MiB, DO_BA = 44 * MiB, DO_GL = 45 * MiB;
constexpr size_t WS_PROJ = 0, WS_H0 = 96 * MiB, WS_FRAGS = 96 * MiB, WS_O32 = 0, WS_ON = 64 * MiB;
constexpr size_t WS_WUP0 = 216 * MiB, WS_WDN0 = 224 * MiB, WS_WQKV = 232 * MiB, WS_WO1 = 238 * MiB, WS_WUP1 = 240 * MiB, WS_WDN1 = 248 * MiB;
constexpr size_t WS_MIX_A = 96 * MiB;
constexpr size_t WS_UP = 64 * MiB;
constexpr size_t WS_QK = 64 * MiB, WS_VT = 128 * MiB;
constexpr int FRAG_CHUNK = 73728;

struct Params {
    const float* in[17];
    float* out;
    unsigned char* ws;
};

DI unsigned pk2(float a, float b) { f32x2 v = {a, b}; return __builtin_bit_cast(unsigned, __builtin_convertvector(v, bf16v2)); }
DI float bflo(unsigned u) { return __uint_as_float(u << 16); }
DI float bfhi(unsigned u) { return __uint_as_float(u & 0xffff0000u); }
DI f32x4 mfma16(bf16x8 a, bf16x8 b, f32x4 c) { return __builtin_amdgcn_mfma_f32_16x16x32_bf16(a, b, c, 0, 0, 0); }
DI bf16x8 mk8(u32x2 lo, u32x2 hi) { u32x4 v = {lo.x, lo.y, hi.x, hi.y}; return __builtin_bit_cast(bf16x8, v); }
DI bf16x8 pack8(f32x4 a, f32x4 b) { u32x4 v = {pk2(a[0], a[1]), pk2(a[2], a[3]), pk2(b[0], b[1]), pk2(b[2], b[3])}; return __builtin_bit_cast(bf16x8, v); }
DI float wave_sum(float v) {
#pragma unroll
    for (int o = 1; o < 64; o <<= 1) v += __shfl_xor(v, o);
    return v;
}
#define LDS_WAIT() asm volatile("s_waitcnt lgkmcnt(0)" ::: "memory")

DI void transpose_item(const float* __restrict__ W, int ldw, int col_off, int N, int K, const float* __restrict__ gain, bf16_t* __restrict__ WT, float* scr, int item, int lane) {
    const int nblk = (N + 31) >> 5, kb = item / nblk, nb = item - kb * nblk, k0 = kb * 64, n0 = nb * 32;
    const int nn = n0 + (lane & 31);
    const bool ok = nn < N;
#pragma unroll 8
    for (int i = 0; i < 32; ++i) {
        const int kk = 2 * i + (lane >> 5);
        float v = ok ? W[(size_t)(k0 + kk) * ldw + col_off + nn] : 0.f;
        if (gain) v *= gain[k0 + kk];
        scr[kk * 33 + (lane & 31)] = v;
    }
    LDS_WAIT();
    const int c = lane & 7;
#pragma unroll
    for (int j = 0; j < 4; ++j) {
        const int n = (lane >> 3) + 8 * j;
        const float* s = scr + (8 * c) * 33 + n;
        u32x4 o = {pk2(s[0], s[33]), pk2(s[66], s[99]), pk2(s[132], s[165]), pk2(s[198], s[231])};
        if (n0 + n < N) *(u32x4*)(WT + (size_t)(n0 + n) * K + k0 + 8 * c) = o;
    }
    LDS_WAIT();
}

template <int MODE>
DI void row_pass(const float* __restrict__ xin, const bf16_t* __restrict__ mix, const float* __restrict__ gain, float* __restrict__ xout, bf16_t* __restrict__ H, int gw, int ngw, int lane) {
    for (int row = gw; row < MTOK; row += ngw) {
        f32x4 v[4];
#pragma unroll
        for (int j = 0; j < 4; ++j) v[j] = *(const f32x4*)(xin + (size_t)row * 1024 + 256 * j + 4 * lane);
        if (MODE >= 1) {
            f32x4 m[4]; float ss = 0.f;
#pragma unroll
            for (int j = 0; j < 4; ++j) {
                const u32x2 r = *(const u32x2*)(mix + (size_t)row * 1024 + 256 * j + 4 * lane);
                m[j] = (f32x4){bflo(r.x), bfhi(r.x), bflo(r.y), bfhi(r.y)};
                ss += (m[j][0] * m[j][0] + m[j][1] * m[j][1]) + (m[j][2] * m[j][2] + m[j][3] * m[j][3]);
            }
            const float rs = rsqrtf(wave_sum(ss) * (1.f / 1024.f) + EPS);
#pragma unroll
            for (int j = 0; j < 4; ++j) {
                const f32x4 g = *(const f32x4*)(gain + 256 * j + 4 * lane);
                v[j] = v[j] + m[j] * rs * g;
                *(f32x4*)(xout + (size_t)row * 1024 + 256 * j + 4 * lane) = v[j];
            }
        }
        if (MODE != 2) {
            float ss = 0.f;
#pragma unroll
            for (int j = 0; j < 4; ++j) ss += (v[j][0] * v[j][0] + v[j][1] * v[j][1]) + (v[j][2] * v[j][2] + v[j][3] * v[j][3]);
            const float rs = rsqrtf(wave_sum(ss) * (1.f / 1024.f) + EPS);
#pragma unroll
            for (int j = 0; j < 4; ++j) {
                u32x2 o = {pk2(v[j][0] * rs, v[j][1] * rs), pk2(v[j][2] * rs, v[j][3] * rs)};
                *(u32x2*)(H + (size_t)row * 1024 + 256 * j + 4 * lane) = o;
            }
        }
    }
}

DI int swz(int row, int c) { return row * 128 + ((c ^ ((row >> 1) & 7)) << 4); }

template <class Epi>
DI void gemm_phase(unsigned char* lds, const bf16_t* __restrict__ A, const bf16_t* __restrict__ Bt, int K, int ntn, const Epi& epi, int vcu, int G) {
    const int tid = threadIdx.x, lane = tid & 63, wid = tid >> 6, wr = wid >> 1, wc = wid & 1, fr = lane & 15, fq = lane >> 4;
    const int nunits = 64 * ntn, nk = K >> 6;
    int arow[4], ac[4], brow[2], bc[2];
#pragma unroll
    for (int i = 0; i < 4; ++i) { const int q = tid + 512 * i; arow[i] = q >> 3; ac[i] = q & 7; }
#pragma unroll
    for (int i = 0; i < 2; ++i) { const int q = tid + 512 * i; brow[i] = q >> 3; bc[i] = q & 7; }
    for (int u = vcu; u < nunits; u += G) {
        const int pm = u / ntn, pn = u - pm * ntn, m0 = pm * 256, n0 = pn * 128;
        const bf16_t* Ap = A + (size_t)m0 * K;
        const bf16_t* Bp = Bt + (size_t)n0 * K;
        f32x4 acc[4][4];
#pragma unroll
        for (int m = 0; m < 4; ++m)
#pragma unroll
            for (int n = 0; n < 4; ++n) acc[m][n] = (f32x4){0.f, 0.f, 0.f, 0.f};
        u32x4 ra[4], rb[2];
#pragma unroll
        for (int i = 0; i < 4; ++i) ra[i] = *(const u32x4*)(Ap + (size_t)arow[i] * K + ac[i] * 8);
#pragma unroll
        for (int i = 0; i < 2; ++i) rb[i] = *(const u32x4*)(Bp + (size_t)brow[i] * K + bc[i] * 8);
#pragma unroll
        for (int i = 0; i < 4; ++i) *(u32x4*)(lds + swz(arow[i], ac[i])) = ra[i];
#pragma unroll
        for (int i = 0; i < 2; ++i) *(u32x4*)(lds + 32768 + swz(brow[i], bc[i])) = rb[i];
        __syncthreads();
        for (int kt = 0; kt < nk; ++kt) {
            const bool more = kt + 1 < nk;
            if (more) {
                const int k0 = (kt + 1) * 64;
#pragma unroll
                for (int i = 0; i < 4; ++i) ra[i] = *(const u32x4*)(Ap + (size_t)arow[i] * K + k0 + ac[i] * 8);
#pragma unroll
                for (int i = 0; i < 2; ++i) rb[i] = *(const u32x4*)(Bp + (size_t)brow[i] * K + k0 + bc[i] * 8);
            }
            const unsigned char* sa = lds + (kt & 1) * 49152;
            const unsigned char* sb = sa + 32768;
#pragma unroll
            for (int ks = 0; ks < 2; ++ks) {
                bf16x8 af[4], bfr[4];
#pragma unroll
                for (int m = 0; m < 4; ++m) af[m] = *(const bf16x8*)(sa + swz(wr * 64 + m * 16 + fr, ks * 4 + fq));
#pragma unroll
                for (int n = 0; n < 4; ++n) bfr[n] = *(const bf16x8*)(sb + swz(wc * 64 + n * 16 + fr, ks * 4 + fq));
#pragma unroll
                for (int m = 0; m < 4; ++m)
#pragma unroll
                    for (int n = 0; n < 4; ++n) acc[m][n] = mfma16(bfr[n], af[m], acc[m][n]);
            }
            if (more) {
                unsigned char* da = lds + ((kt + 1) & 1) * 49152;
#pragma unroll
                for (int i = 0; i < 4; ++i) *(u32x4*)(da + swz(arow[i], ac[i])) = ra[i];
#pragma unroll
                for (int i = 0; i < 2; ++i) *(u32x4*)(da + 32768 + swz(brow[i], bc[i])) = rb[i];
            }
            __syncthreads();
        }
#pragma unroll
        for (int m = 0; m < 4; ++m)
#pragma unroll
            for (int n = 0; n < 4; ++n) epi(m0 + wr * 64 + m * 16 + fr, n0 + wc * 64 + n * 16 + 4 * fq, acc[m][n]);
    }
}

struct EpiP1 {
    bf16_t* qkv; bf16_t* gate;
    DI void operator()(int row, int col, f32x4 v) const {
        u32x2 o = {pk2(v[0], v[1]), pk2(v[2], v[3])};
        if (col < 3072) *(u32x2*)(qkv + (size_t)row * 3072 + col) = o;
        else *(u32x2*)(gate + (size_t)row * 1024 + (col - 3072)) = o;
    }
};
struct EpiBf16 {
    bf16_t* o; int ld;
    DI void operator()(int row, int col, f32x4 v) const { u32x2 w = {pk2(v[0], v[1]), pk2(v[2], v[3])}; *(u32x2*)(o + (size_t)row * ld + col) = w; }
};
struct EpiSqRelu {
    bf16_t* o; int ld;
    DI void operator()(int row, int col, f32x4 v) const {
#pragma unroll
        for (int i = 0; i < 4; ++i) { const float t = fmaxf(v[i], 0.f); v[i] = t * t; }
        u32x2 w = {pk2(v[0], v[1]), pk2(v[2], v[3])}; *(u32x2*)(o + (size_t)row * ld + col) = w;
    }
};
struct EpiQKV {
    bf16_t* qk; bf16_t* vt;
    DI void operator()(int row, int col, f32x4 v) const {
        if (col < 2048) { u32x2 w = {pk2(v[0], v[1]), pk2(v[2], v[3])}; *(u32x2*)(qk + (size_t)row * 2048 + col) = w; }
        else {
            const int c = col - 2048, b = row >> 13, t = row & 8191;
            bf16_t* base = vt + ((size_t)(b * 1024 + c)) * 8192 + t;
            const unsigned w0 = pk2(v[0], v[1]), w1 = pk2(v[2], v[3]);
            base[0] = (bf16_t)(w0 & 0xffff); base[8192] = (bf16_t)(w0 >> 16); base[2 * 8192] = (bf16_t)(w1 & 0xffff); base[3 * 8192] = (bf16_t)(w1 >> 16);
        }
    }
};

DI void skinny16(const bf16_t* __restrict__ A, const bf16_t* __restrict__ Bt16, float* __restrict__ BA, int wu, int lane) {
    const int fr = lane & 15, fq = lane >> 4, r0 = wu * 32;
    f32x4 a0 = {0.f, 0.f, 0.f, 0.f}, a1 = {0.f, 0.f, 0.f, 0.f};
    const bf16_t* ap0 = A + (size_t)(r0 + fr) * 1024 + fq * 8;
    const bf16_t* ap1 = ap0 + 16 * 1024;
    const bf16_t* bp = Bt16 + (size_t)fr * 1024 + fq * 8;
#pragma unroll 4
    for (int ks = 0; ks < 32; ++ks) {
        const bf16x8 b = *(const bf16x8*)(bp + ks * 32);
        a0 = mfma16(b, *(const bf16x8*)(ap0 + ks * 32), a0);
        a1 = mfma16(b, *(const bf16x8*)(ap1 + ks * 32), a1);
    }
    *(f32x4*)(BA + (size_t)(r0 + fr) * 16 + 4 * fq) = a0;
    *(f32x4*)(BA + (size_t)(r0 + 16 + fr) * 16 + 4 * fq) = a1;
}

DI void conv8(const bf16_t* __restrict__ proj, const float* __restrict__ convw, int b, int t, int cc, float* dst) {
    float acc[8];
#pragma unroll
    for (int i = 0; i < 8; ++i) acc[i] = 0.f;
#pragma unroll
    for (int dt = 0; dt < 4; ++dt) {
        const int tt = t - 3 + dt;
        u32x4 raw = {0u, 0u, 0u, 0u};
        if (tt >= 0) raw = *(const u32x4*)(proj + (size_t)(b * T_SEQ + tt) * 3072 + cc);
        const f32x4 w0 = *(const f32x4*)(convw + dt * 3072 + cc), w1 = *(const f32x4*)(convw + dt * 3072 + cc + 4);
        acc[0] += bflo(raw.x) * w0[0]; acc[1] += bfhi(raw.x) * w0[1]; acc[2] += bflo(raw.y) * w0[2]; acc[3] += bfhi(raw.y) * w0[3];
        acc[4] += bflo(raw.z) * w1[0]; acc[5] += bfhi(raw.z) * w1[1]; acc[6] += bflo(raw.w) * w1[2]; acc[7] += bfhi(raw.w) * w1[3];
    }
#pragma unroll
    for (int i = 0; i < 8; ++i) { float r = acc[i] / (1.f + __expf(-acc[i])); asm volatile("" : "+v"(r)); dst[i] = r; }
}

constexpr int P2_SQ = 0, P2_SK = 17408, P2_SQG = 34816, P2_SKGT = 52224, P2_SKGBT = 70656, P2_SVBT = 89088, P2_SL = 107520, P2_STB = 124928, P2_SG = 134144, P2_SGC = 134400, P2_SBETA = 134656;

DI void gdn_prep_chunk(unsigned char* lds, const bf16_t* __restrict__ proj, const float* __restrict__ BA, const float* __restrict__ convw,
                       const float* __restrict__ a_log, const float* __restrict__ dt_bias, unsigned char* __restrict__ frags, float* __restrict__ GL, int cid) {
    int tid_ = threadIdx.x; asm volatile("" : "+v"(tid_));
    const int tid = tid_, lane = tid & 63, wid = __builtin_amdgcn_readfirstlane(tid >> 6), fr = lane & 15, fq = lane >> 4;
    const int bh = cid >> 7, n = cid & 127, b = bh >> 3, h = bh & 7;
    float* sg = (float*)(lds + P2_SG); float* sgc = (float*)(lds + P2_SGC); float* sbeta = (float*)(lds + P2_SBETA);
    float* sL = (float*)(lds + P2_SL);
    unsigned char* fbase = frags + (size_t)cid * FRAG_CHUNK;
    const int row = tid >> 3, cg8 = tid & 7, t = n * 64 + row, grow = b * T_SEQ + t;
    float q[16], k[16], v[16];
    {
        const int c0 = h * 128 + cg8 * 16;
#define CBAR() asm volatile("" ::: "memory")
        conv8(proj, convw, b, t, c0, q); CBAR(); conv8(proj, convw, b, t, c0 + 8, q + 8); CBAR();
        conv8(proj, convw, b, t, 1024 + c0, k); CBAR(); conv8(proj, convw, b, t, 1024 + c0 + 8, k + 8); CBAR();
        conv8(proj, convw, b, t, 2048 + c0, v); CBAR(); conv8(proj, convw, b, t, 2048 + c0 + 8, v + 8); CBAR();
    }
    float sq = 0.f, sk = 0.f;
#pragma unroll
    for (int i = 0; i < 16; ++i) { sq += q[i] * q[i]; sk += k[i] * k[i]; }
    sq += __shfl_xor(sq, 1); sq += __shfl_xor(sq, 2); sq += __shfl_xor(sq, 4);
    sk += __shfl_xor(sk, 1); sk += __shfl_xor(sk, 2); sk += __shfl_xor(sk, 4);
    const float qs = rsqrtf(sq + EPS) * 0.08838834764831845f, ks_ = rsqrtf(sk + EPS);
    const float braw = BA[(size_t)grow * 16 + h], araw = BA[(size_t)grow * 16 + 8 + h];
    const float beta = 1.f / (1.f + expf(-braw));
    const float xsp = araw + dt_bias[h];
    const float gval = -expf(a_log[h]) * (fmaxf(xsp, 0.f) + log1pf(expf(-fabsf(xsp))));
    if (cg8 == 0) { sg[row] = gval; sbeta[row] = beta; }
    __syncthreads();
    if (wid == 0) {
        float x = sg[lane];
#pragma unroll
        for (int off = 1; off < 64; off <<= 1) { const float y = __shfl_up(x, off); if (lane >= off) x += y; }
        sgc[lane] = x;
    }
    __syncthreads();
    {
        const float gc = sgc[row], glast = sgc[63];
        const float ep = expf(gc), ek = expf(glast - gc);
        u32x4 w0, w1;
#define PK16(dst0, dst1, expr) do { float e_[16]; _Pragma("unroll") for (int i = 0; i < 16; ++i) e_[i] = (expr); \
        dst0 = (u32x4){pk2(e_[0], e_[1]), pk2(e_[2], e_[3]), pk2(e_[4], e_[5]), pk2(e_[6], e_[7])}; dst1 = (u32x4){pk2(e_[8], e_[9]), pk2(e_[10], e_[11]), pk2(e_[12], e_[13]), pk2(e_[14], e_[15])}; } while (0)
        PK16(w0, w1, q[i] * qs);
        *(u32x4*)(lds + P2_SQ + row * 272 + cg8 * 32) = w0; *(u32x4*)(lds + P2_SQ + row * 272 + cg8 * 32 + 16) = w1;
        PK16(w0, w1, k[i] * ks_);
        *(u32x4*)(lds + P2_SK + row * 272 + cg8 * 32) = w0; *(u32x4*)(lds + P2_SK + row * 272 + cg8 * 32 + 16) = w1;
        PK16(w0, w1, q[i] * (qs * ep));
        *(u32x4*)(lds + P2_SQG + row * 272 + cg8 * 32) = w0; *(u32x4*)(lds + P2_SQG + row * 272 + cg8 * 32 + 16) = w1;
        bf16_t* sKGT = (bf16_t*)(lds + P2_SKGT); bf16_t* sKGbT = (bf16_t*)(lds + P2_SKGBT); bf16_t* sVbT = (bf16_t*)(lds + P2_SVBT);
        const float kek = ks_ * ek, kbe = ks_ * beta * ep;
#pragma unroll
        for (int i = 0; i < 16; i += 2) {
            const int d = cg8 * 16 + i;
            const unsigned a = pk2(k[i] * kek, k[i + 1] * kek), bb = pk2(k[i] * kbe, k[i + 1] * kbe), c = pk2(v[i] * beta, v[i + 1] * beta);
            sKGT[d * 72 + row] = (bf16_t)(a & 0xffff); sKGT[(d + 1) * 72 + row] = (bf16_t)(a >> 16);
            sKGbT[d * 72 + row] = (bf16_t)(bb & 0xffff); sKGbT[(d + 1) * 72 + row] = (bf16_t)(bb >> 16);
            sVbT[d * 72 + row] = (bf16_t)(c & 0xffff); sVbT[(d + 1) * 72 + row] = (bf16_t)(c >> 16);
        }
        if (tid == 0) GL[cid] = expf(glast);
    }
    __syncthreads();
    {
        const int mi = wid & 3, kc = wid >> 2;
        f32x4 a0 = {0.f, 0.f, 0.f, 0.f}, a1 = {0.f, 0.f, 0.f, 0.f};
#pragma unroll
        for (int ks = 0; ks < 4; ++ks) {
            const bf16x8 qb = *(const bf16x8*)(lds + P2_SQ + (16 * mi + fr) * 272 + ks * 64 + fq * 16);
            const bf16x8 k0 = *(const bf16x8*)(lds + P2_SK + (32 * kc + fr) * 272 + ks * 64 + fq * 16);
            const bf16x8 k1 = *(const bf16x8*)(lds + P2_SK + (32 * kc + 16 + fr) * 272 + ks * 64 + fq * 16);
            a0 = mfma16(k0, qb, a0); a1 = mfma16(k1, qb, a1);
        }
        const int c = 16 * mi + fr; const float gcc = sgc[c];
        f32x4 v0, v1;
#pragma unroll
        for (int r = 0; r < 4; ++r) {
            const int c0 = 32 * kc + 4 * fq + r, c1 = c0 + 16;
            v0[r] = (c >= c0) ? a0[r] * expf(gcc - sgc[c0]) : 0.f;
            v1[r] = (c >= c1) ? a1[r] * expf(gcc - sgc[c1]) : 0.f;
        }
        *(bf16x8*)(fbase + 49152 + ((mi * 2 + kc) * 64 + lane) * 16) = pack8(v0, v1);
        const int it = wid & 3;
#pragma unroll
        for (int jj = 0; jj < 2; ++jj) {
            const int jt = (wid >> 2) * 2 + jj;
            f32x4 acc = {0.f, 0.f, 0.f, 0.f};
#pragma unroll
            for (int ks = 0; ks < 4; ++ks) {
                const bf16x8 ka = *(const bf16x8*)(lds + P2_SK + (16 * it + fr) * 272 + ks * 64 + fq * 16);
                const bf16x8 kb = *(const bf16x8*)(lds + P2_SK + (16 * jt + fr) * 272 + ks * 64 + fq * 16);
                acc = mfma16(ka, kb, acc);
            }
            const int j = 16 * jt + fr; const float gcj = sgc[j];
#pragma unroll
            for (int r = 0; r < 4; ++r) {
                const int i = 16 * it + 4 * fq + r;
                sL[i * 68 + j] = (i > j) ? sbeta[i] * acc[r] * expf(sgc[i] - gcj) : 0.f;
            }
        }
    }
    __syncthreads();
    if (wid == 0) {
        bf16_t* sTb = (bf16_t*)(lds + P2_STB);
        int vz = 0; asm volatile("" : "+v"(vz));
        const float* sLv = sL + vz;
        float x[64];
#pragma unroll
        for (int i = 0; i < 64; ++i) x[i] = 0.f;
#pragma unroll
        for (int i = 0; i < 64; ++i) {
            float a0 = -sL[i * 68 + lane], a1 = 0.f;
#pragma unroll
            for (int mb = 0; mb * 4 < i; ++mb) {
                const f32x4 Lv = *(const f32x4*)(sLv + i * 68 + mb * 4);
                if (mb & 1) { a1 -= Lv[0] * x[4 * mb]; a1 -= Lv[1] * x[4 * mb + 1]; a1 -= Lv[2] * x[4 * mb + 2]; a1 -= Lv[3] * x[4 * mb + 3]; }
                else        { a0 -= Lv[0] * x[4 * mb]; a0 -= Lv[1] * x[4 * mb + 1]; a0 -= Lv[2] * x[4 * mb + 2]; a0 -= Lv[3] * x[4 * mb + 3]; }
            }
            x[i] = a0 + a1;
            sTb[i * 72 + lane] = (bf16_t)(pk2(x[i], 0.f) & 0xffff);
        }
        LDS_WAIT();
        sTb[lane * 72 + lane] = (bf16_t)0x3F80;
    } else {
        for (int slot = tid - 64; slot < 2048; slot += 448) {
            const int f = slot >> 6, l = slot & 63, m = l & 15, g = l >> 4;
            const unsigned char* src; unsigned char* dst;
            if (f < 16) { const int mi = f >> 2, kb = f & 3; src = lds + P2_SQG + (16 * mi + m) * 272 + (32 * kb + 4 * g) * 2; dst = fbase + 16384 + slot * 16; }
            else { const int f2 = f - 16, tt = f2 >> 1, kc = f2 & 1; src = lds + P2_SKGT + (16 * tt + m) * 144 + (32 * kc + 4 * g) * 2; dst = fbase + 32768 + (slot - 1024) * 16; }
            const u32x2 lo = *(const u32x2*)src, hi = *(const u32x2*)(src + 32);
            *(u32x4*)dst = (u32x4){lo.x, lo.y, hi.x, hi.y};
        }
    }
    __syncthreads();
    {
        const int mi = wid & 3;
#pragma unroll
        for (int kk = 0; kk < 2; ++kk) {
            const int kb = (wid >> 2) * 2 + kk;
            f32x4 d0 = {0.f, 0.f, 0.f, 0.f}, d1 = {0.f, 0.f, 0.f, 0.f};
#pragma unroll
            for (int ks = 0; ks < 2; ++ks) {
                const bf16x8 tb = *(const bf16x8*)(lds + P2_STB + (16 * mi + fr) * 144 + ks * 64 + fq * 16);
                const bf16x8 g0 = *(const bf16x8*)(lds + P2_SKGBT + (32 * kb + fr) * 144 + ks * 64 + fq * 16);
                const bf16x8 g1 = *(const bf16x8*)(lds + P2_SKGBT + (32 * kb + 16 + fr) * 144 + ks * 64 + fq * 16);
                d0 = mfma16(g0, tb, d0); d1 = mfma16(g1, tb, d1);
            }
            *(bf16x8*)(fbase + ((mi * 4 + kb) * 64 + lane) * 16) = pack8(d0, d1);
        }
#pragma unroll
        for (int q4 = 0; q4 < 4; ++q4) {
            const int dvt = (wid >> 2) * 4 + q4;
            f32x4 u = {0.f, 0.f, 0.f, 0.f};
#pragma unroll
            for (int ks = 0; ks < 2; ++ks) {
                const bf16x8 ta = *(const bf16x8*)(lds + P2_STB + (16 * mi + fr) * 144 + ks * 64 + fq * 16);
                const bf16x8 vb = *(const bf16x8*)(lds + P2_SVBT + (16 * dvt + fr) * 144 + ks * 64 + fq * 16);
                u = mfma16(ta, vb, u);
            }
            u32x2 o = {pk2(u[0], u[1]), pk2(u[2], u[3])};
            *(u32x2*)(fbase + 57344 + dvt * 2048 + mi * 512 + lane * 8) = o;
        }
    }
    __syncthreads();
}

constexpr int P3_STEP = 59392;
DI void gdn_scan(unsigned char* lds, const unsigned char* __restrict__ frags, const float* __restrict__ GL, float* __restrict__ O, int item) {
    const int tid = threadIdx.x, lane = tid & 63, wid = tid >> 6, fr = lane & 15, fq = lane >> 4;
    const int bh = item >> 3, slice = item & 7, b = bh >> 3, h = bh & 7;
    float* sGL = (float*)(lds + 2 * P3_STEP);
    if (tid < 128) sGL[tid] = GL[bh * 128 + tid];
    const int lt = tid - 64;
    u32x4 rg[9];
    auto issue = [&](int n) {
        const unsigned char* src = frags + (size_t)(bh * 128 + n) * FRAG_CHUNK;
#pragma unroll
        for (int i = 0; i < 9; ++i) {
            const int qq = lt + 448 * i;
            if (qq < 3712) rg[i] = *(const u32x4*)(qq < 3584 ? src + qq * 16 : src + 57344 + slice * 2048 + (qq - 3584) * 16);
        }
    };
    auto commit = [&](int buf) {
        unsigned char* dst = lds + buf * P3_STEP;
#pragma unroll
        for (int i = 0; i < 9; ++i) { const int qq = lt + 448 * i; if (qq < 3712) *(u32x4*)(dst + qq * 16) = rg[i]; }
    };
    if (wid > 0) { issue(0); commit(0); issue(1); }
    f32x4 S[8];
#pragma unroll
    for (int t = 0; t < 8; ++t) S[t] = (f32x4){0.f, 0.f, 0.f, 0.f};
    __syncthreads();
    for (int n = 0; n < 128; ++n) {
        if (wid > 0) {
            if (n + 1 < 128) commit((n + 1) & 1);
            if (n + 2 < 128) issue(n + 2);
        } else {
            const unsigned char* Bf = lds + (n & 1) * P3_STEP;
            const float gl = sGL[n];
            bf16x8 Sb[4];
#pragma unroll
            for (int kb = 0; kb < 4; ++kb) Sb[kb] = pack8(S[2 * kb], S[2 * kb + 1]);
            f32x4 P[4], Oa[4];
#pragma unroll
            for (int mi = 0; mi < 4; ++mi) { P[mi] = (f32x4){0.f, 0.f, 0.f, 0.f}; Oa[mi] = (f32x4){0.f, 0.f, 0.f, 0.f}; }
#pragma unroll
            for (int kb = 0; kb < 4; ++kb)
#pragma unroll
                for (int mi = 0; mi < 4; ++mi) {
                    P[mi] = mfma16(*(const bf16x8*)(Bf + ((mi * 4 + kb) * 64 + lane) * 16), Sb[kb], P[mi]);
                    Oa[mi] = mfma16(*(const bf16x8*)(Bf + 16384 + ((mi * 4 + kb) * 64 + lane) * 16), Sb[kb], Oa[mi]);
                }
            f32x4 vn[4];
#pragma unroll
            for (int mi = 0; mi < 4; ++mi) {
                const u32x2 ur = *(const u32x2*)(Bf + 57344 + mi * 512 + lane * 8);
                vn[mi] = (f32x4){bflo(ur.x), bfhi(ur.x), bflo(ur.y), bfhi(ur.y)} - P[mi];
            }
            bf16x8 Vb[2];
            Vb[0] = pack8(vn[0], vn[1]); Vb[1] = pack8(vn[2], vn[3]);
#pragma unroll
            for (int kc = 0; kc < 2; ++kc)
#pragma unroll
                for (int mi = 0; mi < 4; ++mi) Oa[mi] = mfma16(*(const bf16x8*)(Bf + 49152 + ((mi * 2 + kc) * 64 + lane) * 16), Vb[kc], Oa[mi]);
#pragma unroll
            for (int t = 0; t < 8; ++t) S[t] = S[t] * gl;
#pragma unroll
            for (int kc = 0; kc < 2; ++kc)
#pragma unroll
                for (int t = 0; t < 8; ++t) S[t] = mfma16(*(const bf16x8*)(Bf + 32768 + ((t * 2 + kc) * 64 + lane) * 16), Vb[kc], S[t]);
            float* op = O + ((size_t)(b * T_SEQ + n * 64 + 4 * fq)) * 1024 + h * 128 + slice * 16 + fr;
#pragma unroll
            for (int mi = 0; mi < 4; ++mi)
#pragma unroll
                for (int r = 0; r < 4; ++r) op[(size_t)(16 * mi + r) * 1024] = Oa[mi][r];
        }
        __syncthreads();
    }
}

DI void gated_norm(const float* __restrict__ O, const bf16_t* __restrict__ gate, const float* __restrict__ out_gain, bf16_t* __restrict__ ON, int gw, int ngw, int lane) {
    f32x4 gn[4];
#pragma unroll
    for (int j = 0; j < 4; ++j) gn[j] = *(const f32x4*)(out_gain + ((lane & 7) * 16) + 4 * j);
    for (int row = gw; row < MTOK; row += ngw) {
        f32x4 o[4]; float ss = 0.f;
#pragma unroll
        for (int j = 0; j < 4; ++j) { o[j] = *(const f32x4*)(O + (size_t)row * 1024 + lane * 16 + 4 * j); ss += (o[j][0] * o[j][0] + o[j][1] * o[j][1]) + (o[j][2] * o[j][2] + o[j][3] * o[j][3]); }
        ss += __shfl_xor(ss, 1); ss += __shfl_xor(ss, 2); ss += __shfl_xor(ss, 4);
        const float rs = rsqrtf(ss * (1.f / 128.f) + EPS);
        const u32x4 g0 = *(const u32x4*)(gate + (size_t)row * 1024 + lane * 16), g1 = *(const u32x4*)(gate + (size_t)row * 1024 + lane * 16 + 8);
        float gv[16] = {bflo(g0.x), bfhi(g0.x), bflo(g0.y), bfhi(g0.y), bflo(g0.z), bfhi(g0.z), bflo(g0.w), bfhi(g0.w),
                        bflo(g1.x), bfhi(g1.x), bflo(g1.y), bfhi(g1.y), bflo(g1.z), bfhi(g1.z), bflo(g1.w), bfhi(g1.w)};
        float r[16];
#pragma unroll
        for (int i = 0; i < 16; ++i) { const float g = gv[i]; r[i] = o[i >> 2][i & 3] * rs * gn[i >> 2][i & 3] * (g / (1.f + __expf(-g))); }
        u32x4 w0 = {pk2(r[0], r[1]), pk2(r[2], r[3]), pk2(r[4], r[5]), pk2(r[6], r[7])}, w1 = {pk2(r[8], r[9]), pk2(r[10], r[11]), pk2(r[12], r[13]), pk2(r[14], r[15])};
        *(u32x4*)(ON + (size_t)row * 1024 + lane * 16) = w0; *(u32x4*)(ON + (size_t)row * 1024 + lane * 16 + 8) = w1;
    }
}

DI void sb_attn_task(const bf16_t* __restrict__ QK, const bf16_t* __restrict__ VT, bf16_t* __restrict__ ATT, int task, int lane) {
    const int fr = lane & 15, fq = lane >> 4;
    const int qt = task & 511, bh = task >> 9, b = bh >> 3, h = bh & 7;
    const int t0 = qt * 16, tq = t0 + fr;
    const size_t rowbase = (size_t)b * T_SEQ;
    bf16x8 qf[4];
    {
        const bf16_t* qp = QK + (rowbase + t0 + fr) * 2048 + h * 128 + fq * 8;
#pragma unroll
        for (int ks = 0; ks < 4; ++ks) qf[ks] = *(const bf16x8*)(qp + ks * 32);
    }
    f32x4 oacc[8];
#pragma unroll
    for (int d = 0; d < 8; ++d) oacc[d] = (f32x4){0.f, 0.f, 0.f, 0.f};
    float carry = 0.f;
    const bf16_t* kbase = QK + rowbase * 2048 + 1024 + h * 128 + fq * 8;
    const bf16_t* vbase = VT + ((size_t)bh * 128 + fr) * 8192 + 4 * fq;
    const float scale = 0.08838834764831845f;
    for (int kt = t0 >> 6; kt >= 0; --kt) {
        const int s0 = kt * 64;
        f32x4 z[4];
#pragma unroll
        for (int j = 0; j < 4; ++j) {
            z[j] = (f32x4){0.f, 0.f, 0.f, 0.f};
            const bf16_t* kp = kbase + (size_t)(s0 + 16 * j + fr) * 2048;
#pragma unroll
            for (int ks = 0; ks < 4; ++ks) z[j] = mfma16(*(const bf16x8*)(kp + ks * 32), qf[ks], z[j]);
        }
        f32x4 lb[4], lm[4]; float TT[4], E[4];
#pragma unroll
        for (int j = 0; j < 4; ++j) {
            float Tj = 0.f;
#pragma unroll
            for (int r = 0; r < 4; ++r) {
                const int s = s0 + 16 * j + 4 * fq + r;
                const float zz = z[j][r] * scale;
                const float sp = fmaxf(-zz, 0.f) + __logf(1.f + __expf(-fabsf(zz)));
                lb[j][r] = -sp;
                const float m_ = (s < tq) ? (-sp - zz) : 0.f;
                lm[j][r] = m_; Tj += m_;
            }
            const float b_ = __shfl_xor(Tj, 16); const float c_ = Tj + b_; const float d_ = __shfl_xor(c_, 32);
            TT[j] = c_ + d_;
            E[j] = ((fq & 1) ? 0.f : b_) + ((fq & 2) ? 0.f : d_);
        }
        f32x4 a[4];
        float later = carry;
#pragma unroll
        for (int j = 3; j >= 0; --j) {
            float suf = 0.f;
#pragma unroll
            for (int r = 3; r >= 0; --r) {
                const int s = s0 + 16 * j + 4 * fq + r;
                const float tail = suf + E[j] + later;
                a[j][r] = (s < tq) ? __expf(lb[j][r] + tail) : 0.f;
                suf += lm[j][r];
            }
            later += TT[j];
        }
        carry = later;
        bf16x8 ab[2];
        ab[0] = pack8(a[0], a[1]); ab[1] = pack8(a[2], a[3]);
#pragma unroll
        for (int dt = 0; dt < 8; ++dt)
#pragma unroll
            for (int kc = 0; kc < 2; ++kc) {
                const bf16_t* vp = vbase + (size_t)dt * 16 * 8192 + s0 + 32 * kc;
                const u32x2 lo = *(const u32x2*)vp, hi = *(const u32x2*)(vp + 16);
                oacc[dt] = mfma16(mk8(lo, hi), ab[kc], oacc[dt]);
            }
        if (__all(carry < -120.f)) break;
    }
    bf16_t* op = ATT + (rowbase + t0 + fr) * 1024 + h * 128 + 4 * fq;
#pragma unroll
    for (int dt = 0; dt < 8; ++dt) { u32x2 o = {pk2(oacc[dt][0], oacc[dt][1]), pk2(oacc[dt][2], oacc[dt][3])}; *(u32x2*)(op + 16 * dt) = o; }
}

__global__ void __launch_bounds__(512) yoco_fwd(Params p) {
    extern __shared__ __attribute__((aligned(16))) unsigned char lds[];
    cg::grid_group grid = cg::this_grid();
    const int tid = threadIdx.x, lane = tid & 63, wid = tid >> 6;
    const int G = gridDim.x;
    const int vcu = ((G & 7) == 0) ? ((blockIdx.x & 7) * (G >> 3) + (blockIdx.x >> 3)) : blockIdx.x;
    const int gw = vcu * 8 + wid, ngw = G * 8;
    unsigned char* ws = p.ws;
    unsigned char* dob = (unsigned char*)p.out;
    const float* x = p.in[0];
    float* scr = (float*)(lds + wid * 8448);

    if (PHMASK & (1u << 0))
    {
        bf16_t* WTIN = (bf16_t*)(dob + DO_WTIN); bf16_t* WTOUT0 = (bf16_t*)(dob + DO_WTOUT0);
        const int I_IN = 16 * 129, I_OUT = 16 * 32;
        for (int it = gw; it < I_IN + I_OUT; it += ngw) {
            if (it < I_IN) transpose_item(p.in[7], 4112, 0, 4112, 1024, p.in[1], WTIN, scr, it, lane);
            else transpose_item(p.in[12], 1024, 0, 1024, 1024, nullptr, WTOUT0, scr, it - I_IN, lane);
        }
        row_pass<0>(x, nullptr, nullptr, nullptr, (bf16_t*)(ws + WS_H0), gw, ngw, lane);
    }
    grid.sync();
    if (PHMASK & (1u << 1))
    {
        EpiP1 e{(bf16_t*)(ws + WS_PROJ), (bf16_t*)(dob + DO_GATE)};
        gemm_phase(lds, (const bf16_t*)(ws + WS_H0), (const bf16_t*)(dob + DO_WTIN), 1024, 32, e, vcu, G);
        if (wid < 2) { const int wu = vcu * 2 + wid; if (wu < 512) skinny16((const bf16_t*)(ws + WS_H0), (const bf16_t*)(dob + DO_WTIN) + (size_t)4096 * 1024, (float*)(dob + DO_BA), wu, lane); }
    }
    grid.sync();
    if (PHMASK & (1u << 2))
    for (int cid = vcu; cid < 2048; cid += G)
        gdn_prep_chunk(lds, (const bf16_t*)(ws + WS_PROJ), (const float*)(dob + DO_BA), p.in[8], p.in[9], p.in[10], ws + WS_FRAGS, (float*)(dob + DO_GL), cid);
    grid.sync();
    if (PHMASK & (1u << 3))
    {
        int first, stride;
        if (G == 256) { const int xx = vcu >> 5, j = vcu & 31; first = (j < 16) ? xx * 16 + j : 128; stride = 128; }
        else { first = blockIdx.x; stride = G; }
        for (int item = first; item < 128; item += stride) { gdn_scan(lds, ws + WS_FRAGS, (const float*)(dob + DO_GL), (float*)(ws + WS_O32), item); __syncthreads(); }
    }
    grid.sync();
    if (PHMASK & (1u << 4))
    {
        gated_norm((const float*)(ws + WS_O32), (const bf16_t*)(dob + DO_GATE), p.in[11], (bf16_t*)(ws + WS_ON), gw, ngw, lane);
        const int I0 = 2048, I1 = I0 + 2048, I2 = I1 + 512, I3 = I2 + 1024, I4 = I3 + 512, I5 = I4 + 2048, I6 = I5 + 2048;
        for (int it = gw; it < I6; it += ngw) {
            if (it < I0) transpose_item(p.in[5], 4096, 0, 4096, 1024, p.in[3], (bf16_t*)(ws + WS_WUP0), scr, it, lane);
            else if (it < I1) transpose_item(p.in[6], 1024, 0, 1024, 4096, nullptr, (bf16_t*)(ws + WS_WDN0), scr, it - I0, lane);
            else if (it < I2) transpose_item(p.in[15], 1024, 0, 1024, 1024, p.in[1] + 1024, (bf16_t*)(ws + WS_WQKV), scr, it - I1, lane);
            else if (it < I3) transpose_item(p.in[14], 2048, 0, 2048, 1024, p.in[13], (bf16_t*)(ws + WS_WQKV) + (size_t)1024 * 1024, scr, it - I2, lane);
            else if (it < I4) transpose_item(p.in[16], 1024, 0, 1024, 1024, nullptr, (bf16_t*)(ws + WS_WO1), scr, it - I3, lane);
            else if (it < I5) transpose_item(p.in[5] + (size_t)1024 * 4096, 4096, 0, 4096, 1024, p.in[3] + 1024, (bf16_t*)(ws + WS_WUP1), scr, it - I4, lane);
            else transpose_item(p.in[6] + (size_t)4096 * 1024, 1024, 0, 1024, 4096, nullptr, (bf16_t*)(ws + WS_WDN1), scr, it - I5, lane);
        }
    }
    grid.sync();
    if (PHMASK & (1u << 5))
    { EpiBf16 e{(bf16_t*)(ws + WS_MIX_A), 1024}; gemm_phase(lds, (const bf16_t*)(ws + WS_ON), (const bf16_t*)(dob + DO_WTOUT0), 1024, 8, e, vcu, G); }
    grid.sync();
    if (PHMASK & (1u << 6))
    row_pass<1>(x, (const bf16_t*)(ws + WS_MIX_A), p.in[2], p.out, (bf16_t*)(ws + 0), gw, ngw, lane);
    grid.sync();
    if (PHMASK & (1u << 7))
    { EpiSqRelu e{(bf16_t*)(ws + WS_UP), 4096}; gemm_phase(lds, (const bf16_t*)(ws + 0), (const bf16_t*)(ws + WS_WUP0), 1024, 32, e, vcu, G); }
    grid.sync();
    if (PHMASK & (1u << 8))
    { EpiBf16 e{(bf16_t*)(ws + 0), 1024}; gemm_phase(lds, (const bf16_t*)(ws + WS_UP), (const bf16_t*)(ws + WS_WDN0), 4096, 8, e, vcu, G); }
    grid.sync();
    if (PHMASK & (1u << 9))
    row_pass<1>(p.out, (const bf16_t*)(ws + 0), p.in[4], p.out, (bf16_t*)(ws + 32 * MiB), gw, ngw, lane);
    grid.sync();
    if (PHMASK & (1u << 10))
    { EpiQKV e{(bf16_t*)(ws + WS_QK), (bf16_t*)(ws + WS_VT)}; gemm_phase(lds, (const bf16_t*)(ws + 32 * MiB), (const bf16_t*)(ws + WS_WQKV), 1024, 24, e, vcu, G); }
    grid.sync();
    if (PHMASK & (1u << 11))
    for (int task = gw; task < 8192; task += ngw) sb_attn_task((const bf16_t*)(ws + WS_QK), (const bf16_t*)(ws + WS_VT), (bf16_t*)(ws + 0), task, lane);
    grid.sync();
    if (PHMASK & (1u << 12))
    { EpiBf16 e{(bf16_t*)(ws + 32 * MiB), 1024}; gemm_phase(lds, (const bf16_t*)(ws + 0), (const bf16_t*)(ws + WS_WO1), 1024, 8, e, vcu, G); }
    grid.sync();
    if (PHMASK & (1u << 13))
    row_pass<1>(p.out, (const bf16_t*)(ws + 32 * MiB), p.in[2] + 1024, p.out, (bf16_t*)(ws + 0), gw, ngw, lane);
    grid.sync();
    if (PHMASK & (1u << 14))
    { EpiSqRelu e{(bf16_t*)(ws + WS_UP), 4096}; gemm_phase(lds, (const bf16_t*)(ws + 0), (const bf16_t*)(ws + WS_WUP1), 1024, 32, e, vcu, G); }
    grid.sync();
    if (PHMASK & (1u << 15))
    { EpiBf16 e{(bf16_t*)(ws + 0), 1024}; gemm_phase(lds, (const bf16_t*)(ws + WS_UP), (const bf16_t*)(ws + WS_WDN1), 4096, 8, e, vcu, G); }
    grid.sync();
    if (PHMASK & (1u << 16))
    row_pass<2>(p.out, (const bf16_t*)(ws + 0), p.in[4] + 1024, p.out, nullptr, gw, ngw, lane);
}

extern "C" void kernel_launch(void* const* d_in, const int* in_sizes, int n_in, void* d_out, int out_size, void* d_ws, size_t ws_size, hipStream_t stream) {
    static int grid_blocks = 0;
    if (grid_blocks == 0) {
        if (n_in != 17 || out_size != MTOK * 1024 || ws_size < 256 * MiB) { fprintf(stderr, "kernel_launch: unexpected problem shape (n_in %d out %d ws %zu)\n", n_in, out_size, ws_size); grid_blocks = -1; return; }
        int dev = 0, cus = 0, per_cu = 0;
        hipGetDevice(&dev);
        hipDeviceGetAttribute(&cus, hipDeviceAttributeMultiprocessorCount, dev);
        if (hipFuncSetAttribute((const void*)yoco_fwd, hipFuncAttributeMaxDynamicSharedMemorySize, LDS_BYTES) != hipSuccess) { fprintf(stderr, "kernel_launch: hipFuncSetAttribute failed\n"); grid_blocks = -1; return; }
        hipOccupancyMaxActiveBlocksPerMultiprocessor(&per_cu, (const void*)yoco_fwd, 512, LDS_BYTES);
        if (per_cu < 1) { fprintf(stderr, "kernel_launch: occupancy query says %d blocks per CU\n", per_cu); per_cu = 1; }
        grid_blocks = cus * 1;
    }
    if (grid_blocks < 0) return;
    Params p{};
    for (int i = 0; i < 17; ++i) p.in[i] = (const float*)d_in[i];
    p.out = (float*)d_out; p.ws = (unsigned char*)d_ws;
    void* args[] = {&p};
    hipError_t e = hipLaunchCooperativeKernel((const void*)yoco_fwd, dim3(grid_blocks), dim3(512), args, LDS_BYTES, stream);
    if (e != hipSuccess) fprintf(stderr, "cooperative launch failed: %s (grid %d)\n", hipGetErrorString(e), grid_blocks);
}
```

```cpp
#include <hip/hip_runtime.h>
#include <hip/hip_cooperative_groups.h>
#include <cstdio>
namespace cg = cooperative_groups;

#define DI __device__ __forceinline__
typedef unsigned short bf16_t;
typedef short bf16x8 __attribute__((ext_vector_type(8)));
typedef float f32x4 __attribute__((ext_vector_type(4)));
typedef float f32x2 __attribute__((ext_vector_type(2)));
typedef unsigned u32x4 __attribute__((ext_vector_type(4)));
typedef unsigned u32x2 __attribute__((ext_vector_type(2)));
typedef __bf16 bf16v2 __attribute__((ext_vector_type(2)));

constexpr int T_SEQ = 8192, MTOK = 16384;
constexpr size_t MiB = (size_t)1 << 20;
constexpr int LDS_BYTES = 147456;
constexpr float EPS = 1e-6f;
#ifndef PHREP
#define PHREP 0u
#endif

constexpr size_t DO_GATE = 0, DO_WTIN = 32 * MiB, DO_WTOUT0 = 41 * MiB, DO_BA = 44 * MiB, DO_GL = 45 * MiB;
constexpr size_t WS_PROJ = 0, WS_H0 = 96 * MiB, WS_FRAGS = 96 * MiB, WS_O32 = 0, WS_ON = 64 * MiB;
constexpr size_t WS_WUP0 = 192 * MiB, WS_WDN0 = 200 * MiB, WS_WQKV = 208 * MiB, WS_WO1 = 214 * MiB, WS_WUP1 = 216 * MiB, WS_WDN1 = 224 * MiB;
constexpr size_t WS_BAR = 240 * MiB;
constexpr size_t WS_MIX_A = 96 * MiB;
constexpr size_t WS_UP = 64 * MiB;
constexpr size_t WS_QK = 64 * MiB, WS_VT = 128 * MiB;
constexpr int FRAG_CHUNK = 73728;

struct Params {
    const float* in[17];
    float* out;
    unsigned char* ws;
};

DI unsigned pk2(float a, float b) { f32x2 v = {a, b}; return __builtin_bit_cast(unsigned, __builtin_convertvector(v, bf16v2)); }
DI float bflo(unsigned u) { return __uint_as_float(u << 16); }
DI float bfhi(unsigned u) { return __uint_as_float(u & 0xffff0000u); }
DI f32x4 mfma16(bf16x8 a, bf16x8 b, f32x4 c) { return __builtin_amdgcn_mfma_f32_16x16x32_bf16(a, b, c, 0, 0, 0); }
DI bf16x8 mk8(u32x2 lo, u32x2 hi) { u32x4 v = {lo.x, lo.y, hi.x, hi.y}; return __builtin_bit_cast(bf16x8, v); }
DI bf16x8 pack8(f32x4 a, f32x4 b) { u32x4 v = {pk2(a[0], a[1]), pk2(a[2], a[3]), pk2(b[0], b[1]), pk2(b[2], b[3])}; return __builtin_bit_cast(bf16x8, v); }
DI float wave_sum(float v) {
#pragma unroll
    for (int o = 1; o < 64; o <<= 1) v += __shfl_xor(v, o);
    return v;
}
#define LDS_WAIT() asm volatile("s_waitcnt lgkmcnt(0)" ::: "memory")

#define XB_TMO      128
#define XB_XCNT(j)  (256  + 64 * (j))
#define XB_XSUB(j)  (1280 + 64 * (j))
#define XB_XGEN(j)  (2304 + 64 * (j))
#define XB_TOP      3328
#define XB_TOPGEN   3392
#define XCD_BAR_WORDS 3456
#define XB_SPIN_CAP (1u << 18)
#define LAS __attribute__((address_space(3)))
DI unsigned xb_ld(unsigned* p)              { return __hip_atomic_load(p, __ATOMIC_RELAXED, __HIP_MEMORY_SCOPE_AGENT); }
DI unsigned xb_add(unsigned* p, unsigned v) { return __hip_atomic_fetch_add(p, v, __ATOMIC_RELAXED, __HIP_MEMORY_SCOPE_AGENT); }
DI unsigned xb_xcc_id() { return (unsigned)__builtin_amdgcn_s_getreg((3 << 11) | 20) & 0xFu; }
#define XB_SPIN(cond, bar) do { unsigned _sp = 0; while (cond) { __builtin_amdgcn_s_sleep(1); \
    if ((++_sp & 255u) == 0u) { if (xb_ld(&(bar)[XB_TMO])) break; if (_sp > XB_SPIN_CAP) { atomicAdd(&(bar)[XB_TMO], 1u); break; } } } } while (0)
struct XcdBarrier { unsigned* bar; unsigned x; volatile LAS unsigned* st; };
DI XcdBarrier xcd_barrier_post(unsigned* bar, volatile LAS unsigned* st) {
    XcdBarrier b; b.bar = bar; b.x = xb_xcc_id(); b.st = st;
    if (threadIdx.x == 0) (void)xb_add(&bar[XB_XCNT(b.x)], 1u);
    return b;
}
DI void xcd_barrier_complete(unsigned* bar, unsigned x, unsigned& nloc, unsigned& nx) {
    const unsigned G = gridDim.x * gridDim.y * gridDim.z;
    unsigned sum, cnt, mine, sp = 0u;
    for (;;) {
        sum = 0u; cnt = 0u; mine = 0u;
#pragma unroll
        for (unsigned j = 0; j < 16; ++j) { const unsigned c = xb_ld(&bar[XB_XCNT(j)]); sum += c; cnt += (c > 0u) ? 1u : 0u; mine = (j == x) ? c : mine; }
        if (sum == G) break;
        __builtin_amdgcn_s_sleep(1);
        if ((++sp & 255u) == 0u) { if (xb_ld(&bar[XB_TMO])) break; if (sp > XB_SPIN_CAP) { atomicAdd(&bar[XB_TMO], 1u); break; } }
    }
    nloc = mine > 0u ? mine : 1u; nx = cnt > 0u ? cnt : 1u;
}
DI void xcd_barrier(const XcdBarrier& b) {
    asm volatile("s_waitcnt vmcnt(0)" ::: "memory");
    __syncthreads();
    if (threadIdx.x == 0) {
        unsigned* bar = b.bar;
        __builtin_amdgcn_s_waitcnt(0);
        unsigned nloc = b.st[0], nx = b.st[1];
        if (nloc == 0u) { xcd_barrier_complete(bar, b.x, nloc, nx); b.st[0] = nloc; b.st[1] = nx; }
        const unsigned old = xb_add(&bar[XB_XSUB(b.x)], 1u);
        const unsigned gen = old / nloc;
        if (old + 1u == (gen + 1u) * nloc) {
            __builtin_amdgcn_fence(__ATOMIC_RELEASE, "agent");
            asm volatile("s_waitcnt vmcnt(0)" ::: "memory");
            const unsigned og = xb_add(&bar[XB_TOP], 1u);
            const unsigned tg = og / nx;
            if (og + 1u == (tg + 1u) * nx) xb_add(&bar[XB_TOPGEN], 1u);
            else XB_SPIN(xb_ld(&bar[XB_TOPGEN]) == tg, bar);
            __builtin_amdgcn_fence(__ATOMIC_ACQUIRE, "agent");
            xb_add(&bar[XB_XGEN(b.x)], 1u);
            asm volatile("s_waitcnt vmcnt(0)" ::: "memory");
        } else {
            XB_SPIN(xb_ld(&bar[XB_XGEN(b.x)]) == gen, bar);
            __builtin_amdgcn_fence(__ATOMIC_ACQUIRE, "agent");
            asm volatile("s_waitcnt vmcnt(0)" ::: "memory");
        }
    }
    __syncthreads();
}

DI void transpose_item(const float* __restrict__ W, int ldw, int col_off, int N, int K, const float* __restrict__ gain, bf16_t* __restrict__ WT, float* scr, int item, int lane) {
    const int nblk = (N + 31) >> 5, kb = item / nblk, nb = item - kb * nblk, k0 = kb * 64, n0 = nb * 32;
    const int nn = n0 + (lane & 31);
    const bool ok = nn < N;
#pragma unroll 8
    for (int i = 0; i < 32; ++i) {
        const int kk = 2 * i + (lane >> 5);
        float v = ok ? W[(size_t)(k0 + kk) * ldw + col_off + nn] : 0.f;
        if (gain) v *= gain[k0 + kk];
        scr[kk * 33 + (lane & 31)] = v;
    }
    LDS_WAIT();
    const int c = lane & 7;
#pragma unroll
    for (int j = 0; j < 4; ++j) {
        const int n = (lane >> 3) + 8 * j;
        const float* s = scr + (8 * c) * 33 + n;
        u32x4 o = {pk2(s[0], s[33]), pk2(s[66], s[99]), pk2(s[132], s[165]), pk2(s[198], s[231])};
        if (n0 + n < N) *(u32x4*)(WT + (size_t)(n0 + n) * K + k0 + 8 * c) = o;
    }
    LDS_WAIT();
}

template <int MODE>
DI void row_pass(const float* __restrict__ xin, const bf16_t* __restrict__ mix, const float* __restrict__ gain, float* __restrict__ xout, bf16_t* __restrict__ H, int gw, int ngw, int lane) {
    for (int row = gw; row < MTOK; row += ngw) {
        f32x4 v[4];
#pragma unroll
        for (int j = 0; j < 4; ++j) v[j] = *(const f32x4*)(xin + (size_t)row * 1024 + 256 * j + 4 * lane);
        if (MODE >= 1) {
            f32x4 m[4]; float ss = 0.f;
#pragma unroll
            for (int j = 0; j < 4; ++j) {
                const u32x2 r = *(const u32x2*)(mix + (size_t)row * 1024 + 256 * j + 4 * lane);
                m[j] = (f32x4){bflo(r.x), bfhi(r.x), bflo(r.y), bfhi(r.y)};
                ss += (m[j][0] * m[j][0] + m[j][1] * m[j][1]) + (m[j][2] * m[j][2] + m[j][3] * m[j][3]);
            }
            const float rs = rsqrtf(wave_sum(ss) * (1.f / 1024.f) + EPS);
#pragma unroll
            for (int j = 0; j < 4; ++j) {
                const f32x4 g = *(const f32x4*)(gain + 256 * j + 4 * lane);
                v[j] = v[j] + m[j] * rs * g;
                *(f32x4*)(xout + (size_t)row * 1024 + 256 * j + 4 * lane) = v[j];
            }
        }
        if (MODE != 2) {
            float ss = 0.f;
#pragma unroll
            for (int j = 0; j < 4; ++j) ss += (v[j][0] * v[j][0] + v[j][1] * v[j][1]) + (v[j][2] * v[j][2] + v[j][3] * v[j][3]);
            const float rs = rsqrtf(wave_sum(ss) * (1.f / 1024.f) + EPS);
#pragma unroll
            for (int j = 0; j < 4; ++j) {
                u32x2 o = {pk2(v[j][0] * rs, v[j][1] * rs), pk2(v[j][2] * rs, v[j][3] * rs)};
                *(u32x2*)(H + (size_t)row * 1024 + 256 * j + 4 * lane) = o;
            }
        }
    }
}

DI int swz(int row, int c) { return row * 128 + ((c ^ ((row >> 1) & 7)) << 4); }

template <class Epi>
DI void gemm_phase(unsigned char* lds, const bf16_t* __restrict__ A, const bf16_t* __restrict__ Bt, int K, int ntn, const Epi& epi, int vcu, int G) {
    const int tid = threadIdx.x, lane = tid & 63, wid = tid >> 6, wr = wid >> 1, wc = wid & 1, fr = lane & 15, fq = lane >> 4;
    const int nunits = 64 * ntn, nk = K >> 6;
    int arow[4], ac[4], brow[2], bc[2];
#pragma unroll
    for (int i = 0; i < 4; ++i) { const int q = tid + 512 * i; arow[i] = q >> 3; ac[i] = q & 7; }
#pragma unroll
    for (int i = 0; i < 2; ++i) { const int q = tid + 512 * i; brow[i] = q >> 3; bc[i] = q & 7; }
    for (int u = vcu; u < nunits; u += G) {
        const int pm = u / ntn, pn = u - pm * ntn, m0 = pm * 256, n0 = pn * 128;
        const bf16_t* Ap = A + (size_t)m0 * K;
        const bf16_t* Bp = Bt + (size_t)n0 * K;
        f32x4 acc[4][4];
#pragma unroll
        for (int m = 0; m < 4; ++m)
#pragma unroll
            for (int n = 0; n < 4; ++n) acc[m][n] = (f32x4){0.f, 0.f, 0.f, 0.f};
        u32x4 ra[4], rb[2];
#pragma unroll
        for (int i = 0; i < 4; ++i) ra[i] = *(const u32x4*)(Ap + (size_t)arow[i] * K + ac[i] * 8);
#pragma unroll
        for (int i = 0; i < 2; ++i) rb[i] = *(const u32x4*)(Bp + (size_t)brow[i] * K + bc[i] * 8);
#pragma unroll
        for (int i = 0; i < 4; ++i) *(u32x4*)(lds + swz(arow[i], ac[i])) = ra[i];
#pragma unroll
        for (int i = 0; i < 2; ++i) *(u32x4*)(lds + 32768 + swz(brow[i], bc[i])) = rb[i];
        __syncthreads();
        for (int kt = 0; kt < nk; ++kt) {
            const bool more = kt + 1 < nk;
            if (more) {
                const int k0 = (kt + 1) * 64;
#pragma unroll
                for (int i = 0; i < 4; ++i) ra[i] = *(const u32x4*)(Ap + (size_t)arow[i] * K + k0 + ac[i] * 8);
#pragma unroll
                for (int i = 0; i < 2; ++i) rb[i] = *(const u32x4*)(Bp + (size_t)brow[i] * K + k0 + bc[i] * 8);
            }
            const unsigned char* sa = lds + (kt & 1) * 49152;
            const unsigned char* sb = sa + 32768;
#pragma unroll
            for (int ks = 0; ks < 2; ++ks) {
                bf16x8 af[4], bfr[4];
#pragma unroll
                for (int m = 0; m < 4; ++m) af[m] = *(const bf16x8*)(sa + swz(wr * 64 + m * 16 + fr, ks * 4 + fq));
#pragma unroll
                for (int n = 0; n < 4; ++n) bfr[n] = *(const bf16x8*)(sb + swz(wc * 64 + n * 16 + fr, ks * 4 + fq));
#pragma unroll
                for (int m = 0; m < 4; ++m)
#pragma unroll
                    for (int n = 0; n < 4; ++n) acc[m][n] = mfma16(bfr[n], af[m], acc[m][n]);
            }
            if (more) {
                unsigned char* da = lds + ((kt + 1) & 1) * 49152;
#pragma unroll
                for (int i = 0; i < 4; ++i) *(u32x4*)(da + swz(arow[i], ac[i])) = ra[i];
#pragma unroll
                for (int i = 0; i < 2; ++i) *(u32x4*)(da + 32768 + swz(brow[i], bc[i])) = rb[i];
            }
            __syncthreads();
        }
#pragma unroll
        for (int m = 0; m < 4; ++m)
#pragma unroll
            for (int n = 0; n < 4; ++n) epi(m0 + wr * 64 + m * 16 + fr, n0 + wc * 64 + n * 16 + 4 * fq, acc[m][n]);
    }
}

struct EpiP1 {
    bf16_t* qkv; bf16_t* gate;
    DI void operator()(int row, int col, f32x4 v) const {
        u32x2 o = {pk2(v[0], v[1]), pk2(v[2], v[3])};
        if (col < 3072) *(u32x2*)(qkv + (size_t)row * 3072 + col) = o;
        else *(u32x2*)(gate + (size_t)row * 1024 + (col - 3072)) = o;
    }
};
struct EpiBf16 {
    bf16_t* o; int ld;
    DI void operator()(int row, int col, f32x4 v) const { u32x2 w = {pk2(v[0], v[1]), pk2(v[2], v[3])}; *(u32x2*)(o + (size_t)row * ld + col) = w; }
};
struct EpiSqRelu {
    bf16_t* o; int ld;
    DI void operator()(int row, int col, f32x4 v) const {
#pragma unroll
        for (int i = 0; i < 4; ++i) { const float t = fmaxf(v[i], 0.f); v[i] = t * t; }
        u32x2 w = {pk2(v[0], v[1]), pk2(v[2], v[3])}; *(u32x2*)(o + (size_t)row * ld + col) = w;
    }
};
struct EpiQKV {
    bf16_t* qk; bf16_t* vt;
    DI void operator()(int row, int col, f32x4 v) const {
        if (col < 2048) { u32x2 w = {pk2(v[0], v[1]), pk2(v[2], v[3])}; *(u32x2*)(qk + (size_t)row * 2048 + col) = w; }
        else {
            const int c = col - 2048, b = row >> 13, t = row & 8191;
            bf16_t* base = vt + ((size_t)(b * 1024 + c)) * 8192 + t;
            const unsigned w0 = pk2(v[0], v[1]), w1 = pk2(v[2], v[3]);
            base[0] = (bf16_t)(w0 & 0xffff); base[8192] = (bf16_t)(w0 >> 16); base[2 * 8192] = (bf16_t)(w1 & 0xffff); base[3 * 8192] = (bf16_t)(w1 >> 16);
        }
    }
};

DI void skinny16(const bf16_t* __restrict__ A, const bf16_t* __restrict__ Bt16, float* __restrict__ BA, int wu, int lane) {
    const int fr = lane & 15, fq = lane >> 4, r0 = wu * 32;
    f32x4 a0 = {0.f, 0.f, 0.f, 0.f}, a1 = {0.f, 0.f, 0.f, 0.f};
    const bf16_t* ap0 = A + (size_t)(r0 + fr) * 1024 + fq * 8;
    const bf16_t* ap1 = ap0 + 16 * 1024;
    const bf16_t* bp = Bt16 + (size_t)fr * 1024 + fq * 8;
#pragma unroll 4
    for (int ks = 0; ks < 32; ++ks) {
        const bf16x8 b = *(const bf16x8*)(bp + ks * 32);
        a0 = mfma16(b, *(const bf16x8*)(ap0 + ks * 32), a0);
        a1 = mfma16(b, *(const bf16x8*)(ap1 + ks * 32), a1);
    }
    *(f32x4*)(BA + (size_t)(r0 + fr) * 16 + 4 * fq) = a0;
    *(f32x4*)(BA + (size_t)(r0 + 16 + fr) * 16 + 4 * fq) = a1;
}

DI void conv8(const bf16_t* __restrict__ proj, const float* __restrict__ convw, int b, int t, int cc, float* dst) {
    float acc[8];
#pragma unroll
    for (int i = 0; i < 8; ++i) acc[i] = 0.f;
#pragma unroll
    for (int dt = 0; dt < 4; ++dt) {
        const int tt = t - 3 + dt;
        u32x4 raw = {0u, 0u, 0u, 0u};
        if (tt >= 0) raw = *(const u32x4*)(proj + (size_t)(b * T_SEQ + tt) * 3072 + cc);
        const f32x4 w0 = *(const f32x4*)(convw + dt * 3072 + cc), w1 = *(const f32x4*)(convw + dt * 3072 + cc + 4);
        acc[0] += bflo(raw.x) * w0[0]; acc[1] += bfhi(raw.x) * w0[1]; acc[2] += bflo(raw.y) * w0[2]; acc[3] += bfhi(raw.y) * w0[3];
        acc[4] += bflo(raw.z) * w1[0]; acc[5] += bfhi(raw.z) * w1[1]; acc[6] += bflo(raw.w) * w1[2]; acc[7] += bfhi(raw.w) * w1[3];
    }
#pragma unroll
    for (int i = 0; i < 8; ++i) { float r = acc[i] / (1.f + __expf(-acc[i])); asm volatile("" : "+v"(r)); dst[i] = r; }
}

constexpr int P2_SQ = 0, P2_SK = 17408, P2_SQG = 34816, P2_SKGT = 52224, P2_SKGBT = 70656, P2_SVBT = 89088, P2_SL = 107520, P2_STB = 124928, P2_SG = 134144, P2_SGC = 134400, P2_SBETA = 134656;

DI void gdn_prep_chunk(unsigned char* lds, const bf16_t* __restrict__ proj, const float* __restrict__ BA, const float* __restrict__ convw,
                       const float* __restrict__ a_log, const float* __restrict__ dt_bias, unsigned char* __restrict__ frags, float* __restrict__ GL, int cid) {
    int tid_ = threadIdx.x; asm volatile("" : "+v"(tid_));
    const int tid = tid_, lane = tid & 63, wid = __builtin_amdgcn_readfirstlane(tid >> 6), fr = lane & 15, fq = lane >> 4;
    const int bh = cid >> 7, n = cid & 127, b = bh >> 3, h = bh & 7;
    float* sg = (float*)(lds + P2_SG); float* sgc = (float*)(lds + P2_SGC); float* sbeta = (float*)(lds + P2_SBETA);
    float* sL = (float*)(lds + P2_SL);
    unsigned char* fbase = frags + (size_t)cid * FRAG_CHUNK;
    const int row = tid >> 3, cg8 = tid & 7, t = n * 64 + row, grow = b * T_SEQ + t;
    float q[16], k[16], v[16];
    {
        const int c0 = h * 128 + cg8 * 16;
#define CBAR() asm volatile("" ::: "memory")
        conv8(proj, convw, b, t, c0, q); CBAR(); conv8(proj, convw, b, t, c0 + 8, q + 8); CBAR();
        conv8(proj, convw, b, t, 1024 + c0, k); CBAR(); conv8(proj, convw, b, t, 1024 + c0 + 8, k + 8); CBAR();
        conv8(proj, convw, b, t, 2048 + c0, v); CBAR(); conv8(proj, convw, b, t, 2048 + c0 + 8, v + 8); CBAR();
    }
    float sq = 0.f, sk = 0.f;
#pragma unroll
    for (int i = 0; i < 16; ++i) { sq += q[i] * q[i]; sk += k[i] * k[i]; }
    sq += __shfl_xor(sq, 1); sq += __shfl_xor(sq, 2); sq += __shfl_xor(sq, 4);
    sk += __shfl_xor(sk, 1); sk += __shfl_xor(sk, 2); sk += __shfl_xor(sk, 4);
    const float qs = rsqrtf(sq + EPS) * 0.08838834764831845f, ks_ = rsqrtf(sk + EPS);
    const float braw = BA[(size_t)grow * 16 + h], araw = BA[(size_t)grow * 16 + 8 + h];
    const float beta = 1.f / (1.f + expf(-braw));
    const float xsp = araw + dt_bias[h];
    const float gval = -expf(a_log[h]) * (fmaxf(xsp, 0.f) + log1pf(expf(-fabsf(xsp))));
    if (cg8 == 0) { sg[row] = gval; sbeta[row] = beta; }
    __syncthreads();
    if (wid == 0) {
        float x = sg[lane];
#pragma unroll
        for (int off = 1; off < 64; off <<= 1) { const float y = __shfl_up(x, off); if (lane >= off) x += y; }
        sgc[lane] = x;
    }
    __syncthreads();
    {
        const float gc = sgc[row], glast = sgc[63];
        const float ep = expf(gc), ek = expf(glast - gc);
        u32x4 w0, w1;
#define PK16(dst0, dst1, expr) do { float e_[16]; _Pragma("unroll") for (int i = 0; i < 16; ++i) e_[i] = (expr); \
        dst0 = (u32x4){pk2(e_[0], e_[1]), pk2(e_[2], e_[3]), pk2(e_[4], e_[5]), pk2(e_[6], e_[7])}; dst1 = (u32x4){pk2(e_[8], e_[9]), pk2(e_[10], e_[11]), pk2(e_[12], e_[13]), pk2(e_[14], e_[15])}; } while (0)
        PK16(w0, w1, q[i] * qs);
        *(u32x4*)(lds + P2_SQ + row * 272 + cg8 * 32) = w0; *(u32x4*)(lds + P2_SQ + row * 272 + cg8 * 32 + 16) = w1;
        PK16(w0, w1, k[i] * ks_);
        *(u32x4*)(lds + P2_SK + row * 272 + cg8 * 32) = w0; *(u32x4*)(lds + P2_SK + row * 272 + cg8 * 32 + 16) = w1;
        PK16(w0, w1, q[i] * (qs * ep));
        *(u32x4*)(lds + P2_SQG + row * 272 + cg8 * 32) = w0; *(u32x4*)(lds + P2_SQG + row * 272 + cg8 * 32 + 16) = w1;
        bf16_t* sKGT = (bf16_t*)(lds + P2_SKGT); bf16_t* sKGbT = (bf16_t*)(lds + P2_SKGBT); bf16_t* sVbT = (bf16_t*)(lds + P2_SVBT);
        const float kek = ks_ * ek, kbe = ks_ * beta * ep;
#pragma unroll
        for (int i = 0; i < 16; i += 2) {
            const int d = cg8 * 16 + i;
            const unsigned a = pk2(k[i] * kek, k[i + 1] * kek), bb = pk2(k[i] * kbe, k[i + 1] * kbe), c = pk2(v[i] * beta, v[i + 1] * beta);
            sKGT[d * 72 + row] = (bf16_t)(a & 0xffff); sKGT[(d + 1) * 72 + row] = (bf16_t)(a >> 16);
            sKGbT[d * 72 + row] = (bf16_t)(bb & 0xffff); sKGbT[(d + 1) * 72 + row] = (bf16_t)(bb >> 16);
            sVbT[d * 72 + row] = (bf16_t)(c & 0xffff); sVbT[(d + 1) * 72 + row] = (bf16_t)(c >> 16);
        }
        if (tid == 0) GL[cid] = expf(glast);
    }
    __syncthreads();
    {
        const int mi = wid & 3, kc = wid >> 2;
        f32x4 a0 = {0.f, 0.f, 0.f, 0.f}, a1 = {0.f, 0.f, 0.f, 0.f};
#pragma unroll
        for (int ks = 0; ks < 4; ++ks) {
            const bf16x8 qb = *(const bf16x8*)(lds + P2_SQ + (16 * mi + fr) * 272 + ks * 64 + fq * 16);
            const bf16x8 k0 = *(const bf16x8*)(lds + P2_SK + (32 * kc + fr) * 272 + ks * 64 + fq * 16);
            const bf16x8 k1 = *(const bf16x8*)(lds + P2_SK + (32 * kc + 16 + fr) * 272 + ks * 64 + fq * 16);
            a0 = mfma16(k0, qb, a0); a1 = mfma16(k1, qb, a1);
        }
        const int c = 16 * mi + fr; const float gcc = sgc[c];
        f32x4 v0, v1;
#pragma unroll
        for (int r = 0; r < 4; ++r) {
            const int c0 = 32 * kc + 4 * fq + r, c1 = c0 + 16;
            v0[r] = (c >= c0) ? a0[r] * expf(gcc - sgc[c0]) : 0.f;
            v1[r] = (c >= c1) ? a1[r] * expf(gcc - sgc[c1]) : 0.f;
        }
        *(bf16x8*)(fbase + 49152 + ((mi * 2 + kc) * 64 + lane) * 16) = pack8(v0, v1);
        const int it = wid & 3;
#pragma unroll
        for (int jj = 0; jj < 2; ++jj) {
            const int jt = (wid >> 2) * 2 + jj;
            f32x4 acc = {0.f, 0.f, 0.f, 0.f};
#pragma unroll
            for (int ks = 0; ks < 4; ++ks) {
                const bf16x8 ka = *(const bf16x8*)(lds + P2_SK + (16 * it + fr) * 272 + ks * 64 + fq * 16);
                const bf16x8 kb = *(const bf16x8*)(lds + P2_SK + (16 * jt + fr) * 272 + ks * 64 + fq * 16);
                acc = mfma16(ka, kb, acc);
            }
            const int j = 16 * jt + fr; const float gcj = sgc[j];
#pragma unroll
            for (int r = 0; r < 4; ++r) {
                const int i = 16 * it + 4 * fq + r;
                sL[i * 68 + j] = (i > j) ? sbeta[i] * acc[r] * expf(sgc[i] - gcj) : 0.f;
            }
        }
    }
    __syncthreads();
    if (wid == 0) {
        bf16_t* sTb = (bf16_t*)(lds + P2_STB);
        int vz = 0; asm volatile("" : "+v"(vz));
        const float* sLv = sL + vz;
        float x[64];
#pragma unroll
        for (int i = 0; i < 64; ++i) x[i] = 0.f;
#pragma unroll
        for (int i = 0; i < 64; ++i) {
            float a0 = -sL[i * 68 + lane], a1 = 0.f;
#pragma unroll
            for (int mb = 0; mb * 4 < i; ++mb) {
                const f32x4 Lv = *(const f32x4*)(sLv + i * 68 + mb * 4);
                if (mb & 1) { a1 -= Lv[0] * x[4 * mb]; a1 -= Lv[1] * x[4 * mb + 1]; a1 -= Lv[2] * x[4 * mb + 2]; a1 -= Lv[3] * x[4 * mb + 3]; }
                else        { a0 -= Lv[0] * x[4 * mb]; a0 -= Lv[1] * x[4 * mb + 1]; a0 -= Lv[2] * x[4 * mb + 2]; a0 -= Lv[3] * x[4 * mb + 3]; }
            }
            x[i] = a0 + a1;
            sTb[i * 72 + lane] = (bf16_t)(pk2(x[i], 0.f) & 0xffff);
        }
        LDS_WAIT();
        sTb[lane * 72 + lane] = (bf16_t)0x3F80;
    } else {
        for (int slot = tid - 64; slot < 2048; slot += 448) {
            const int f = slot >> 6, l = slot & 63, m = l & 15, g = l >> 4;
            const unsigned char* src; unsigned char* dst;
            if (f < 16) { const int mi = f >> 2, kb = f & 3; src = lds + P2_SQG + (16 * mi + m) * 272 + (32 * kb + 4 * g) * 2; dst = fbase + 16384 + slot * 16; }
            else { const int f2 = f - 16, tt = f2 >> 1, kc = f2 & 1; src = lds + P2_SKGT + (16 * tt + m) * 144 + (32 * kc + 4 * g) * 2; dst = fbase + 32768 + (slot - 1024) * 16; }
            const u32x2 lo = *(const u32x2*)src, hi = *(const u32x2*)(src + 32);
            *(u32x4*)dst = (u32x4){lo.x, lo.y, hi.x, hi.y};
        }
    }
    __syncthreads();
    {
        const int mi = wid & 3;
#pragma unroll
        for (int kk = 0; kk < 2; ++kk) {
            const int kb = (wid >> 2) * 2 + kk;
            f32x4 d0 = {0.f, 0.f, 0.f, 0.f}, d1 = {0.f, 0.f, 0.f, 0.f};
#pragma unroll
            for (int ks = 0; ks < 2; ++ks) {
                const bf16x8 tb = *(const bf16x8*)(lds + P2_STB + (16 * mi + fr) * 144 + ks * 64 + fq * 16);
                const bf16x8 g0 = *(const bf16x8*)(lds + P2_SKGBT + (32 * kb + fr) * 144 + ks * 64 + fq * 16);
                const bf16x8 g1 = *(const bf16x8*)(lds + P2_SKGBT + (32 * kb + 16 + fr) * 144 + ks * 64 + fq * 16);
                d0 = mfma16(g0, tb, d0); d1 = mfma16(g1, tb, d1);
            }
            *(bf16x8*)(fbase + ((mi * 4 + kb) * 64 + lane) * 16) = pack8(d0, d1);
        }
#pragma unroll
        for (int q4 = 0; q4 < 4; ++q4) {
            const int dvt = (wid >> 2) * 4 + q4;
            f32x4 u = {0.f, 0.f, 0.f, 0.f};
#pragma unroll
            for (int ks = 0; ks < 2; ++ks) {
                const bf16x8 ta = *(const bf16x8*)(lds + P2_STB + (16 * mi + fr) * 144 + ks * 64 + fq * 16);
                const bf16x8 vb = *(const bf16x8*)(lds + P2_SVBT + (16 * dvt + fr) * 144 + ks * 64 + fq * 16);
                u = mfma16(ta, vb, u);
            }
            u32x2 o = {pk2(u[0], u[1]), pk2(u[2], u[3])};
            *(u32x2*)(fbase + 57344 + dvt * 2048 + mi * 512 + lane * 8) = o;
        }
    }
    __syncthreads();
}

constexpr int P3_STEP = 59392;
DI void gdn_scan(unsigned char* lds, const unsigned char* __restrict__ frags, const float* __restrict__ GL, float* __restrict__ O, int item) {
    const int tid = threadIdx.x, lane = tid & 63, wid = tid >> 6, fr = lane & 15, fq = lane >> 4;
    const int bh = item >> 3, slice = item & 7, b = bh >> 3, h = bh & 7;
    float* sGL = (float*)(lds + 2 * P3_STEP);
    if (tid < 128) sGL[tid] = GL[bh * 128 + tid];
    const int lt = tid - 64;
    u32x4 rg[9];
    auto issue = [&](int n) {
        const unsigned char* src = frags + (size_t)(bh * 128 + n) * FRAG_CHUNK;
#pragma unroll
        for (int i = 0; i < 9; ++i) {
            const int qq = lt + 448 * i;
            if (qq < 3712) rg[i] = *(const u32x4*)(qq < 3584 ? src + qq * 16 : src + 57344 + slice * 2048 + (qq - 3584) * 16);
        }
    };
    auto commit = [&](int buf) {
        unsigned char* dst = lds + buf * P3_STEP;
#pragma unroll
        for (int i = 0; i < 9; ++i) { const int qq = lt + 448 * i; if (qq < 3712) *(u32x4*)(dst + qq * 16) = rg[i]; }
    };
    if (wid > 0) { issue(0); commit(0); issue(1); }
    f32x4 S[8];
#pragma unroll
    for (int t = 0; t < 8; ++t) S[t] = (f32x4){0.f, 0.f, 0.f, 0.f};
    __syncthreads();
    for (int n = 0; n < 128; ++n) {
        if (wid > 0) {
            if (n + 1 < 128) commit((n + 1) & 1);
            if (n + 2 < 128) issue(n + 2);
        } else {
            const unsigned char* Bf = lds + (n & 1) * P3_STEP;
            const float gl = sGL[n];
            bf16x8 Sb[4];
#pragma unroll
            for (int kb = 0; kb < 4; ++kb) Sb[kb] = pack8(S[2 * kb], S[2 * kb + 1]);
            f32x4 P[4], Oa[4];
#pragma unroll
            for (int mi = 0; mi < 4; ++mi) { P[mi] = (f32x4){0.f, 0.f, 0.f, 0.f}; Oa[mi] = (f32x4){0.f, 0.f, 0.f, 0.f}; }
#pragma unroll
            for (int kb = 0; kb < 4; ++kb)
#pragma unroll
                for (int mi = 0; mi < 4; ++mi) {
                    P[mi] = mfma16(*(const bf16x8*)(Bf + ((mi * 4 + kb) * 64 + lane) * 16), Sb[kb], P[mi]);
                    Oa[mi] = mfma16(*(const bf16x8*)(Bf + 16384 + ((mi * 4 + kb) * 64 + lane) * 16), Sb[kb], Oa[mi]);
                }
            f32x4 vn[4];
#pragma unroll
            for (int mi = 0; mi < 4; ++mi) {
                const u32x2 ur = *(const u32x2*)(Bf + 57344 + mi * 512 + lane * 8);
                vn[mi] = (f32x4){bflo(ur.x), bfhi(ur.x), bflo(ur.y), bfhi(ur.y)} - P[mi];
            }
            bf16x8 Vb[2];
            Vb[0] = pack8(vn[0], vn[1]); Vb[1] = pack8(vn[2], vn[3]);
#pragma unroll
            for (int kc = 0; kc < 2; ++kc)
#pragma unroll
                for (int mi = 0; mi < 4; ++mi) Oa[mi] = mfma16(*(const bf16x8*)(Bf + 49152 + ((mi * 2 + kc) * 64 + lane) * 16), Vb[kc], Oa[mi]);
#pragma unroll
            for (int t = 0; t < 8; ++t) S[t] = S[t] * gl;
#pragma unroll
            for (int kc = 0; kc < 2; ++kc)
#pragma unroll
                for (int t = 0; t < 8; ++t) S[t] = mfma16(*(const bf16x8*)(Bf + 32768 + ((t * 2 + kc) * 64 + lane) * 16), Vb[kc], S[t]);
            float* op = O + ((size_t)(b * T_SEQ + n * 64 + 4 * fq)) * 1024 + h * 128 + slice * 16 + fr;
#pragma unroll
            for (int mi = 0; mi < 4; ++mi)
#pragma unroll
                for (int r = 0; r < 4; ++r) op[(size_t)(16 * mi + r) * 1024] = Oa[mi][r];
        }
        __syncthreads();
    }
}

DI void gated_norm(const float* __restrict__ O, const bf16_t* __restrict__ gate, const float* __restrict__ out_gain, bf16_t* __restrict__ ON, int gw, int ngw, int lane) {
    f32x4 gn[4];
#pragma unroll
    for (int j = 0; j < 4; ++j) gn[j] = *(const f32x4*)(out_gain + ((lane & 7) * 16) + 4 * j);
    for (int row = gw; row < MTOK; row += ngw) {
        f32x4 o[4]; float ss = 0.f;
#pragma unroll
        for (int j = 0; j < 4; ++j) { o[j] = *(const f32x4*)(O + (size_t)row * 1024 + lane * 16 + 4 * j); ss += (o[j][0] * o[j][0] + o[j][1] * o[j][1]) + (o[j][2] * o[j][2] + o[j][3] * o[j][3]); }
        ss += __shfl_xor(ss, 1); ss += __shfl_xor(ss, 2); ss += __shfl_xor(ss, 4);
        const float rs = rsqrtf(ss * (1.f / 128.f) + EPS);
        const u32x4 g0 = *(const u32x4*)(gate + (size_t)row * 1024 + lane * 16), g1 = *(const u32x4*)(gate + (size_t)row * 1024 + lane * 16 + 8);
        float gv[16] = {bflo(g0.x), bfhi(g0.x), bflo(g0.y), bfhi(g0.y), bflo(g0.z), bfhi(g0.z), bflo(g0.w), bfhi(g0.w),
                        bflo(g1.x), bfhi(g1.x), bflo(g1.y), bfhi(g1.y), bflo(g1.z), bfhi(g1.z), bflo(g1.w), bfhi(g1.w)};
        float r[16];
#pragma unroll
        for (int i = 0; i < 16; ++i) { const float g = gv[i]; r[i] = o[i >> 2][i & 3] * rs * gn[i >> 2][i & 3] * (g / (1.f + __expf(-g))); }
        u32x4 w0 = {pk2(r[0], r[1]), pk2(r[2], r[3]), pk2(r[4], r[5]), pk2(r[6], r[7])}, w1 = {pk2(r[8], r[9]), pk2(r[10], r[11]), pk2(r[12], r[13]), pk2(r[14], r[15])};
        *(u32x4*)(ON + (size_t)row * 1024 + lane * 16) = w0; *(u32x4*)(ON + (size_t)row * 1024 + lane * 16 + 8) = w1;
    }
}

DI void sb_attn_task(const bf16_t* __restrict__ QK, const bf16_t* __restrict__ VT, bf16_t* __restrict__ ATT, int task, int lane) {
    const int fr = lane & 15, fq = lane >> 4;
    const int qt = task & 511, bh = task >> 9, b = bh >> 3, h = bh & 7;
    const int t0 = qt * 16, tq = t0 + fr;
    const size_t rowbase = (size_t)b * T_SEQ;
    bf16x8 qf[4];
    {
        const bf16_t* qp = QK + (rowbase + t0 + fr) * 2048 + h * 128 + fq * 8;
#pragma unroll
        for (int ks = 0; ks < 4; ++ks) qf[ks] = *(const bf16x8*)(qp + ks * 32);
    }
    f32x4 oacc[8];
#pragma unroll
    for (int d = 0; d < 8; ++d) oacc[d] = (f32x4){0.f, 0.f, 0.f, 0.f};
    float carry = 0.f;
    const bf16_t* kbase = QK + rowbase * 2048 + 1024 + h * 128 + fq * 8;
    const bf16_t* vbase = VT + ((size_t)bh * 128 + fr) * 8192 + 4 * fq;
    const float scale = 0.08838834764831845f;
    for (int kt = t0 >> 6; kt >= 0; --kt) {
        const int s0 = kt * 64;
        f32x4 z[4];
#pragma unroll
        for (int j = 0; j < 4; ++j) {
            z[j] = (f32x4){0.f, 0.f, 0.f, 0.f};
            const bf16_t* kp = kbase + (size_t)(s0 + 16 * j + fr) * 2048;
#pragma unroll
            for (int ks = 0; ks < 4; ++ks) z[j] = mfma16(*(const bf16x8*)(kp + ks * 32), qf[ks], z[j]);
        }
        f32x4 lb[4], lm[4]; float TT[4], E[4];
#pragma unroll
        for (int j = 0; j < 4; ++j) {
            float Tj = 0.f;
#pragma unroll
            for (int r = 0; r < 4; ++r) {
                const int s = s0 + 16 * j + 4 * fq + r;
                const float zz = z[j][r] * scale;
                const float sp = fmaxf(-zz, 0.f) + __logf(1.f + __expf(-fabsf(zz)));
                lb[j][r] = -sp;
                const float m_ = (s < tq) ? (-sp - zz) : 0.f;
                lm[j][r] = m_; Tj += m_;
            }
            const float b_ = __shfl_xor(Tj, 16); const float c_ = Tj + b_; const float d_ = __shfl_xor(c_, 32);
            TT[j] = c_ + d_;
            E[j] = ((fq & 1) ? 0.f : b_) + ((fq & 2) ? 0.f : d_);
        }
        f32x4 a[4];
        float later = carry;
#pragma unroll
        for (int j = 3; j >= 0; --j) {
            float suf = 0.f;
#pragma unroll
            for (int r = 3; r >= 0; --r) {
                const int s = s0 + 16 * j + 4 * fq + r;
                const float tail = suf + E[j] + later;
                a[j][r] = (s < tq) ? __expf(lb[j][r] + tail) : 0.f;
                suf += lm[j][r];
            }
            later += TT[j];
        }
        carry = later;
        bf16x8 ab[2];
        ab[0] = pack8(a[0], a[1]); ab[1] = pack8(a[2], a[3]);
#pragma unroll
        for (int dt = 0; dt < 8; ++dt)
#pragma unroll
            for (int kc = 0; kc < 2; ++kc) {
                const bf16_t* vp = vbase + (size_t)dt * 16 * 8192 + s0 + 32 * kc;
                const u32x2 lo = *(const u32x2*)vp, hi = *(const u32x2*)(vp + 16);
                oacc[dt] = mfma16(mk8(lo, hi), ab[kc], oacc[dt]);
            }
        if (__all(carry < -120.f)) break;
    }
    bf16_t* op = ATT + (rowbase + t0 + fr) * 1024 + h * 128 + 4 * fq;
#pragma unroll
    for (int dt = 0; dt < 8; ++dt) { u32x2 o = {pk2(oacc[dt][0], oacc[dt][1]), pk2(oacc[dt][2], oacc[dt][3])}; *(u32x2*)(op + 16 * dt) = o; }
}

__global__ void __launch_bounds__(512) yoco_fwd(Params p) {
    extern __shared__ __attribute__((aligned(16))) unsigned char lds[];
    cg::grid_group grid = cg::this_grid();
    const int tid = threadIdx.x, lane = tid & 63, wid = tid >> 6;
    const int G = gridDim.x;
    const int vcu = ((G & 7) == 0) ? ((blockIdx.x & 7) * (G >> 3) + (blockIdx.x >> 3)) : blockIdx.x;
    const int gw = vcu * 8 + wid, ngw = G * 8;
    unsigned char* ws = p.ws;
    unsigned char* dob = (unsigned char*)p.out;
    const float* x = p.in[0];
    float* scr = (float*)(lds + wid * 8448);
    if (tid < 4) ((unsigned*)(lds + 147440))[tid] = 0u;
    __syncthreads();
    const XcdBarrier xb = xcd_barrier_post((unsigned*)(ws + WS_BAR), (volatile LAS unsigned*)(lds + 147440));

    for (int rep_ = 0; rep_ < 1 + (int)((PHREP >> 0) & 1u); ++rep_)
    {
        bf16_t* WTIN = (bf16_t*)(dob + DO_WTIN); bf16_t* WTOUT0 = (bf16_t*)(dob + DO_WTOUT0);
        const int I_IN = 16 * 129, I_OUT = 16 * 32;
        for (int it = gw; it < I_IN + I_OUT; it += ngw) {
            if (it < I_IN) transpose_item(p.in[7], 4112, 0, 4112, 1024, p.in[1], WTIN, scr, it, lane);
            else transpose_item(p.in[12], 1024, 0, 1024, 1024, nullptr, WTOUT0, scr, it - I_IN, lane);
        }
        row_pass<0>(x, nullptr, nullptr, nullptr, (bf16_t*)(ws + WS_H0), gw, ngw, lane);
    }
    grid.sync();
#ifdef SYNCREP
    for (int i_ = 0; i_ < SYNCREP; ++i_) xcd_barrier(xb);
#endif
    for (int rep_ = 0; rep_ < 1 + (int)((PHREP >> 1) & 1u); ++rep_)
    {
        EpiP1 e{(bf16_t*)(ws + WS_PROJ), (bf16_t*)(dob + DO_GATE)};
        gemm_phase(lds, (const bf16_t*)(ws + WS_H0), (const bf16_t*)(dob + DO_WTIN), 1024, 32, e, vcu, G);
        if (wid < 2) { const int wu = vcu * 2 + wid; if (wu < 512) skinny16((const bf16_t*)(ws + WS_H0), (const bf16_t*)(dob + DO_WTIN) + (size_t)4096 * 1024, (float*)(dob + DO_BA), wu, lane); }
    }
    xcd_barrier(xb);
    for (int rep_ = 0; rep_ < 1 + (int)((PHREP >> 2) & 1u); ++rep_)
    for (int cid = vcu; cid < 2048; cid += G)
        gdn_prep_chunk(lds, (const bf16_t*)(ws + WS_PROJ), (const float*)(dob + DO_BA), p.in[8], p.in[9], p.in[10], ws + WS_FRAGS, (float*)(dob + DO_GL), cid);
    xcd_barrier(xb);
    for (int rep_ = 0; rep_ < 1 + (int)((PHREP >> 3) & 1u); ++rep_)
    {
        int first, stride;
        if (G == 256) { const int xx = vcu >> 5, j = vcu & 31; first = (j < 16) ? xx * 16 + j : 128; stride = 128; }
        else { first = blockIdx.x; stride = G; }
        for (int item = first; item < 128; item += stride) { gdn_scan(lds, ws + WS_FRAGS, (const float*)(dob + DO_GL), (float*)(ws + WS_O32), item); __syncthreads(); }
    }
    xcd_barrier(xb);
    for (int rep_ = 0; rep_ < 1 + (int)((PHREP >> 4) & 1u); ++rep_)
    {
        gated_norm((const float*)(ws + WS_O32), (const bf16_t*)(dob + DO_GATE), p.in[11], (bf16_t*)(ws + WS_ON), gw, ngw, lane);
        const int I0 = 2048, I1 = I0 + 2048, I2 = I1 + 512, I3 = I2 + 1024, I4 = I3 + 512, I5 = I4 + 2048, I6 = I5 + 2048;
        for (int it = gw; it < I6; it += ngw) {
            if (it < I0) transpose_item(p.in[5], 4096, 0, 4096, 1024, p.in[3], (bf16_t*)(ws + WS_WUP0), scr, it, lane);
            else if (it < I1) transpose_item(p.in[6], 1024, 0, 1024, 4096, nullptr, (bf16_t*)(ws + WS_WDN0), scr, it - I0, lane);
            else if (it < I2) transpose_item(p.in[15], 1024, 0, 1024, 1024, p.in[1] + 1024, (bf16_t*)(ws + WS_WQKV), scr, it - I1, lane);
            else if (it < I3) transpose_item(p.in[14], 2048, 0, 2048, 1024, p.in[13], (bf16_t*)(ws + WS_WQKV) + (size_t)1024 * 1024, scr, it - I2, lane);
            else if (it < I4) transpose_item(p.in[16], 1024, 0, 1024, 1024, nullptr, (bf16_t*)(ws + WS_WO1), scr, it - I3, lane);
            else if (it < I5) transpose_item(p.in[5] + (size_t)1024 * 4096, 4096, 0, 4096, 1024, p.in[3] + 1024, (bf16_t*)(ws + WS_WUP1), scr, it - I4, lane);
            else transpose_item(p.in[6] + (size_t)4096 * 1024, 1024, 0, 1024, 4096, nullptr, (bf16_t*)(ws + WS_WDN1), scr, it - I5, lane);
        }
    }
    xcd_barrier(xb);
    for (int rep_ = 0; rep_ < 1 + (int)((PHREP >> 5) & 1u); ++rep_)
    { EpiBf16 e{(bf16_t*)(ws + WS_MIX_A), 1024}; gemm_phase(lds, (const bf16_t*)(ws + WS_ON), (const bf16_t*)(dob + DO_WTOUT0), 1024, 8, e, vcu, G); }
    xcd_barrier(xb);
    for (int rep_ = 0; rep_ < 1 + (int)((PHREP >> 6) & 1u); ++rep_)
    row_pass<1>(x, (const bf16_t*)(ws + WS_MIX_A), p.in[2], p.out, (bf16_t*)(ws + 0), gw, ngw, lane);
    xcd_barrier(xb);
    for (int rep_ = 0; rep_ < 1 + (int)((PHREP >> 7) & 1u); ++rep_)
    { EpiSqRelu e{(bf16_t*)(ws + WS_UP), 4096}; gemm_phase(lds, (const bf16_t*)(ws + 0), (const bf16_t*)(ws + WS_WUP0), 1024, 32, e, vcu, G); }
    xcd_barrier(xb);
    for (int rep_ = 0; rep_ < 1 + (int)((PHREP >> 8) & 1u); ++rep_)
    { EpiBf16 e{(bf16_t*)(ws + 0), 1024}; gemm_phase(lds, (const bf16_t*)(ws + WS_UP), (const bf16_t*)(ws + WS_WDN0), 4096, 8, e, vcu, G); }
    xcd_barrier(xb);
    for (int rep_ = 0; rep_ < 1 + (int)((PHREP >> 9) & 1u); ++rep_)
    row_pass<1>(p.out, (const bf16_t*)(ws + 0), p.in[4], p.out, (bf16_t*)(ws + 32 * MiB), gw, ngw, lane);
    xcd_barrier(xb);
    for (int rep_ = 0; rep_ < 1 + (int)((PHREP >> 10) & 1u); ++rep_)
    { EpiQKV e{(bf16_t*)(ws + WS_QK), (bf16_t*)(ws + WS_VT)}; gemm_phase(lds, (const bf16_t*)(ws + 32 * MiB), (const bf16_t*)(ws + WS_WQKV), 1024, 24, e, vcu, G); }
    xcd_barrier(xb);
    for (int rep_ = 0; rep_ < 1 + (int)((PHREP >> 11) & 1u); ++rep_)
    for (int task = gw; task < 8192; task += ngw) sb_attn_task((const bf16_t*)(ws + WS_QK), (const bf16_t*)(ws + WS_VT), (bf16_t*)(ws + 0), task, lane);
    xcd_barrier(xb);
    for (int rep_ = 0; rep_ < 1 + (int)((PHREP >> 12) & 1u); ++rep_)
    { EpiBf16 e{(bf16_t*)(ws + 32 * MiB), 1024}; gemm_phase(lds, (const bf16_t*)(ws + 0), (const bf16_t*)(ws + WS_WO1), 1024, 8, e, vcu, G); }
    xcd_barrier(xb);
    for (int rep_ = 0; rep_ < 1 + (int)((PHREP >> 13) & 1u); ++rep_)
    row_pass<1>(p.out, (const bf16_t*)(ws + 32 * MiB), p.in[2] + 1024, p.out, (bf16_t*)(ws + 0), gw, ngw, lane);
    xcd_barrier(xb);
    for (int rep_ = 0; rep_ < 1 + (int)((PHREP >> 14) & 1u); ++rep_)
    { EpiSqRelu e{(bf16_t*)(ws + WS_UP), 4096}; gemm_phase(lds, (const bf16_t*)(ws + 0), (const bf16_t*)(ws + WS_WUP1), 1024, 32, e, vcu, G); }
    xcd_barrier(xb);
    for (int rep_ = 0; rep_ < 1 + (int)((PHREP >> 15) & 1u); ++rep_)
    { EpiBf16 e{(bf16_t*)(ws + 0), 1024}; gemm_phase(lds, (const bf16_t*)(ws + WS_UP), (const bf16_t*)(ws + WS_WDN1), 4096, 8, e, vcu, G); }
    xcd_barrier(xb);
    for (int rep_ = 0; rep_ < 1 + (int)((PHREP >> 16) & 1u); ++rep_)
    row_pass<2>(p.out, (const bf16_t*)(ws + 0), p.in[4] + 1024, p.out, nullptr, gw, ngw, lane);
}

extern "C" void kernel_launch(void* const* d_in, const int* in_sizes, int n_in, void* d_out, int out_size, void* d_ws, size_t ws_size, hipStream_t stream) {
    static int grid_blocks = 0;
    if (grid_blocks == 0) {
        if (n_in != 17 || out_size != MTOK * 1024 || ws_size < 256 * MiB) { fprintf(stderr, "kernel_launch: unexpected problem shape (n_in %d out %d ws %zu)\n", n_in, out_size, ws_size); grid_blocks = -1; return; }
        int dev = 0, cus = 0, per_cu = 0;
        hipGetDevice(&dev);
        hipDeviceGetAttribute(&cus, hipDeviceAttributeMultiprocessorCount, dev);
        if (hipFuncSetAttribute((const void*)yoco_fwd, hipFuncAttributeMaxDynamicSharedMemorySize, LDS_BYTES) != hipSuccess) { fprintf(stderr, "kernel_launch: hipFuncSetAttribute failed\n"); grid_blocks = -1; return; }
        hipOccupancyMaxActiveBlocksPerMultiprocessor(&per_cu, (const void*)yoco_fwd, 512, LDS_BYTES);
        if (per_cu < 1) { fprintf(stderr, "kernel_launch: occupancy query says %d blocks per CU\n", per_cu); per_cu = 1; }
        grid_blocks = cus * 1;
    }
    if (grid_blocks < 0) return;
    if (hipMemsetAsync((char*)d_ws + WS_BAR, 0, XCD_BAR_WORDS * 4, stream) != hipSuccess) { fprintf(stderr, "kernel_launch: memset of barrier words failed\n"); return; }
    Params p{};
    for (int i = 0; i < 17; ++i) p.in[i] = (const float*)d_in[i];
    p.out = (float*)d_out; p.ws = (unsigned char*)d_ws;
    void* args[] = {&p};
    hipError_t e = hipLaunchCooperativeKernel((const void*)yoco_fwd, dim3(grid_blocks), dim3(512), args, LDS_BYTES, stream);
    if (e != hipSuccess) fprintf(stderr, "cooperative launch failed: %s (grid %d)\n", hipGetErrorString(e), grid_blocks);
}
```

```cpp
#include <hip/hip_runtime.h>
#include <hip/hip_cooperative_groups.h>
#include <cstdio>
namespace cg = cooperative_groups;

#define DI __device__ __forceinline__
typedef unsigned short bf16_t;
typedef short bf16x8 __attribute__((ext_vector_type(8)));
typedef float f32x4 __attribute__((ext_vector_type(4)));
typedef float f32x2 __attribute__((ext_vector_type(2)));
typedef unsigned u32x4 __attribute__((ext_vector_type(4)));
typedef unsigned u32x2 __attribute__((ext_vector_type(2)));
typedef __bf16 bf16v2 __attribute__((ext_vector_type(2)));

constexpr int T_SEQ = 8192, MTOK = 16384;
constexpr size_t MiB = (size_t)1 << 20;
constexpr int LDS_BYTES = 147456;
constexpr float EPS = 1e-6f;
#ifndef PHREP
#define PHREP 0u
#endif

constexpr size_t DO_GATE = 0, DO_WTIN = 32 * MiB, DO_WTOUT0 = 41 * MiB, DO_BA = 44 * MiB, DO_GL = 45 * MiB;
constexpr size_t WS_PROJ = 0, WS_H0 = 96 * MiB, WS_FRAGS = 96 * MiB, WS_O32 = 0, WS_ON = 64 * MiB;
constexpr size_t WS_WUP0 = 192 * MiB, WS_WDN0 = 200 * MiB, WS_WQKV = 208 * MiB, WS_WO1 = 214 * MiB, WS_WUP1 = 216 * MiB, WS_WDN1 = 224 * MiB;
constexpr size_t WS_BAR = 240 * MiB;
constexpr size_t WS_MIX_A = 96 * MiB;
constexpr size_t WS_UP = 64 * MiB;
constexpr size_t WS_QK = 64 * MiB, WS_VT = 128 * MiB;
constexpr int FRAG_CHUNK = 73728;

struct Params {
    const float* in[17];
    float* out;
    unsigned char* ws;
};

DI unsigned pk2(float a, float b) { f32x2 v = {a, b}; return __builtin_bit_cast(unsigned, __builtin_convertvector(v, bf16v2)); }
DI float bflo(unsigned u) { return __uint_as_float(u << 16); }
DI float bfhi(unsigned u) { return __uint_as_float(u & 0xffff0000u); }
DI f32x4 mfma16(bf16x8 a, bf16x8 b, f32x4 c) { return __builtin_amdgcn_mfma_f32_16x16x32_bf16(a, b, c, 0, 0, 0); }
DI bf16x8 mk8(u32x2 lo, u32x2 hi) { u32x4 v = {lo.x, lo.y, hi.x, hi.y}; return __builtin_bit_cast(bf16x8, v); }
DI bf16x8 pack8(f32x4 a, f32x4 b) { u32x4 v = {pk2(a[0], a[1]), pk2(a[2], a[3]), pk2(b[0], b[1]), pk2(b[2], b[3])}; return __builtin_bit_cast(bf16x8, v); }
DI float wave_sum(float v) {
#pragma unroll
    for (int o = 1; o < 64; o <<= 1) v += __shfl_xor(v, o);
    return v;
}
#define LDS_WAIT() asm volatile("s_waitcnt lgkmcnt(0)" ::: "memory")

#define XB_TMO      128
#define XB_XCNT(j)  (256  + 64 * (j))
#define XB_XSUB(j)  (1280 + 64 * (j))
#define XB_XGEN(j)  (2304 + 64 * (j))
#define XB_TOP      3328
#define XB_TOPGEN   3392
#define XCD_BAR_WORDS 3456
#define XB_SPIN_CAP (1u << 18)
#define LAS __attribute__((address_space(3)))
DI unsigned xb_ld(unsigned* p)              { return __hip_atomic_load(p, __ATOMIC_RELAXED, __HIP_MEMORY_SCOPE_AGENT); }
DI unsigned xb_add(unsigned* p, unsigned v) { return __hip_atomic_fetch_add(p, v, __ATOMIC_RELAXED, __HIP_MEMORY_SCOPE_AGENT); }
DI unsigned xb_xcc_id() { return (unsigned)__builtin_amdgcn_s_getreg((3 << 11) | 20) & 0xFu; }
#define XB_SPIN(cond, bar) do { unsigned _sp = 0; while (cond) { __builtin_amdgcn_s_sleep(1); \
    if ((++_sp & 255u) == 0u) { if (xb_ld(&(bar)[XB_TMO])) break; if (_sp > XB_SPIN_CAP) { atomicAdd(&(bar)[XB_TMO], 1u); break; } } } } while (0)
struct XcdBarrier { unsigned* bar; unsigned x; volatile LAS unsigned* st; };
DI XcdBarrier xcd_barrier_post(unsigned* bar, volatile LAS unsigned* st) {
    XcdBarrier b; b.bar = bar; b.x = xb_xcc_id(); b.st = st;
    if (threadIdx.x == 0) (void)xb_add(&bar[XB_XCNT(b.x)], 1u);
    return b;
}
DI void xcd_barrier_complete(unsigned* bar, unsigned x, unsigned& nloc, unsigned& nx) {
    const unsigned G = gridDim.x * gridDim.y * gridDim.z;
    unsigned sum, cnt, mine, sp = 0u;
    for (;;) {
        sum = 0u; cnt = 0u; mine = 0u;
#pragma unroll
        for (unsigned j = 0; j < 16; ++j) { const unsigned c = xb_ld(&bar[XB_XCNT(j)]); sum += c; cnt += (c > 0u) ? 1u : 0u; mine = (j == x) ? c : mine; }
        if (sum == G) break;
        __builtin_amdgcn_s_sleep(1);
        if ((++sp & 255u) == 0u) { if (xb_ld(&bar[XB_TMO])) break; if (sp > XB_SPIN_CAP) { atomicAdd(&bar[XB_TMO], 1u); break; } }
    }
    nloc = mine > 0u ? mine : 1u; nx = cnt > 0u ? cnt : 1u;
}
DI void xcd_barrier(const XcdBarrier& b) {
    asm volatile("s_waitcnt vmcnt(0)" ::: "memory");
    __syncthreads();
    if (threadIdx.x == 0) {
        unsigned* bar = b.bar;
        __builtin_amdgcn_s_waitcnt(0);
        unsigned nloc = b.st[0], nx = b.st[1];
        if (nloc == 0u) { xcd_barrier_complete(bar, b.x, nloc, nx); b.st[0] = nloc; b.st[1] = nx; }
        const unsigned old = xb_add(&bar[XB_XSUB(b.x)], 1u);
        const unsigned gen = old / nloc;
        if (old + 1u == (gen + 1u) * nloc) {
            __builtin_amdgcn_fence(__ATOMIC_RELEASE, "agent");
            asm volatile("s_waitcnt vmcnt(0)" ::: "memory");
            const unsigned og = xb_add(&bar[XB_TOP], 1u);
            const unsigned tg = og / nx;
            if (og + 1u == (tg + 1u) * nx) xb_add(&bar[XB_TOPGEN], 1u);
            else XB_SPIN(xb_ld(&bar[XB_TOPGEN]) == tg, bar);
            __builtin_amdgcn_fence(__ATOMIC_ACQUIRE, "agent");
            xb_add(&bar[XB_XGEN(b.x)], 1u);
            asm volatile("s_waitcnt vmcnt(0)" ::: "memory");
        } else {
            XB_SPIN(xb_ld(&bar[XB_XGEN(b.x)]) == gen, bar);
            __builtin_amdgcn_fence(__ATOMIC_ACQUIRE, "agent");
            asm volatile("s_waitcnt vmcnt(0)" ::: "memory");
        }
    }
    __syncthreads();
}

DI void transpose_item(const float* __restrict__ W, int ldw, int col_off, int N, int K, const float* __restrict__ gain, bf16_t* __restrict__ WT, float* scr, int item, int lane) {
    const int nblk = (N + 31) >> 5, kb = item / nblk, nb = item - kb * nblk, k0 = kb * 64, n0 = nb * 32;
    const int nn = n0 + (lane & 31);
    const bool ok = nn < N;
#pragma unroll 8
    for (int i = 0; i < 32; ++i) {
        const int kk = 2 * i + (lane >> 5);
        float v = ok ? W[(size_t)(k0 + kk) * ldw + col_off + nn] : 0.f;
        if (gain) v *= gain[k0 + kk];
        scr[kk * 33 + (lane & 31)] = v;
    }
    LDS_WAIT();
    const int c = lane & 7;
#pragma unroll
    for (int j = 0; j < 4; ++j) {
        const int n = (lane >> 3) + 8 * j;
        const float* s = scr + (8 * c) * 33 + n;
        u32x4 o = {pk2(s[0], s[33]), pk2(s[66], s[99]), pk2(s[132], s[165]), pk2(s[198], s[231])};
        if (n0 + n < N) *(u32x4*)(WT + (size_t)(n0 + n) * K + k0 + 8 * c) = o;
    }
    LDS_WAIT();
}

template <int MODE>
DI void row_pass(const float* __restrict__ xin, const bf16_t* __restrict__ mix, const float* __restrict__ gain, float* __restrict__ xout, bf16_t* __restrict__ H, int gw, int ngw, int lane) {
    for (int row0 = gw; row0 < MTOK; row0 += 2 * ngw) {
        f32x4 v[2][4]; u32x2 mr[2][4];
#pragma unroll
        for (int u = 0; u < 2; ++u) {
            const size_t ro = (size_t)(row0 + u * ngw) * 1024 + 4 * lane;
#pragma unroll
            for (int j = 0; j < 4; ++j) v[u][j] = *(const f32x4*)(xin + ro + 256 * j);
            if (MODE >= 1) {
#pragma unroll
                for (int j = 0; j < 4; ++j) mr[u][j] = *(const u32x2*)(mix + ro + 256 * j);
            }
        }
#pragma unroll
        for (int u = 0; u < 2; ++u) {
            const size_t ro = (size_t)(row0 + u * ngw) * 1024 + 4 * lane;
            if (MODE >= 1) {
                f32x4 m[4]; float ss = 0.f;
#pragma unroll
                for (int j = 0; j < 4; ++j) {
                    m[j] = (f32x4){bflo(mr[u][j].x), bfhi(mr[u][j].x), bflo(mr[u][j].y), bfhi(mr[u][j].y)};
                    ss += (m[j][0] * m[j][0] + m[j][1] * m[j][1]) + (m[j][2] * m[j][2] + m[j][3] * m[j][3]);
                }
                const float rs = rsqrtf(wave_sum(ss) * (1.f / 1024.f) + EPS);
#pragma unroll
                for (int j = 0; j < 4; ++j) {
                    const f32x4 g = *(const f32x4*)(gain + 256 * j + 4 * lane);
                    v[u][j] = v[u][j] + m[j] * rs * g;
                    *(f32x4*)(xout + ro + 256 * j) = v[u][j];
                }
            }
            if (MODE != 2) {
                float ss = 0.f;
#pragma unroll
                for (int j = 0; j < 4; ++j) ss += (v[u][j][0] * v[u][j][0] + v[u][j][1] * v[u][j][1]) + (v[u][j][2] * v[u][j][2] + v[u][j][3] * v[u][j][3]);
                const float rs = rsqrtf(wave_sum(ss) * (1.f / 1024.f) + EPS);
#pragma unroll
                for (int j = 0; j < 4; ++j) {
                    u32x2 o = {pk2(v[u][j][0] * rs, v[u][j][1] * rs), pk2(v[u][j][2] * rs, v[u][j][3] * rs)};
                    *(u32x2*)(H + ro + 256 * j) = o;
                }
            }
        }
    }
}

namespace pg8 {
#define PG8_LAS __attribute__((address_space(3)))
typedef unsigned short bf16_t;
typedef short bf16x8 __attribute__((ext_vector_type(8)));
typedef float f32x4 __attribute__((ext_vector_type(4)));
typedef unsigned u32x4 __attribute__((ext_vector_type(4)));
constexpr int BM = 256, BK = 64, HALF = 128, HTB = HALF * BK * 2  , STAGE_BYTES = 8 * HTB, NXCD = 8, WGM = 8;

__host__ __device__ __forceinline__ int lds_byte(int r, int c) { const int st = (r >> 4) * 2 + (c >> 5), rr = r & 15, cc = c & 31, ob = rr * 64 + cc * 2; return st * 1024 + (ob ^ (((ob >> 9) & 1) << 5)); }
__host__ __device__ __forceinline__ void stage_rc(int b, int& R, int& C) { const int st = b / 1024, sb = b % 1024, swz = sb ^ (((sb >> 9) & 1) << 5); R = (st >> 1) * 16 + swz / 64; C = (st & 1) * 32 + (swz % 64) / 2; }
__host__ __device__ __forceinline__ int perm32(int rho) { const int n = rho >> 4, i = rho & 15; return 8 * (i >> 2) + 4 * n + (i & 3); }

struct Unit { int pm, pn; };
struct Gemm { const bf16_t* A; const bf16_t* Bt; int M, N, K; };

struct StaticOrder {
    int nM, nN, nwg, G, c;
    __host__ __device__ void init(int M, int N, int G_, int c_) { nM = M / BM; nN = N / BM; nwg = nM * nN; G = G_; c = c_; }
    __host__ __device__ bool next(int i, Unit& u) const {
        const long L = (long)i * G + c; if (L >= nwg) return false;
        int wgid = (int)L; { const int q = nwg / NXCD, r = nwg % NXCD, xcd = wgid % NXCD, off = wgid / NXCD; wgid = (xcd < r ? xcd * (q + 1) : r * (q + 1) + (xcd - r) * q) + off; }
        const int nig = WGM * nN, gid = wgid / nig, fm = gid * WGM, gsz = (nM - fm) < WGM ? (nM - fm) : WGM;
        u.pm = fm + ((wgid % nig) % gsz); u.pn = (wgid % nig) / gsz; return true;
    }
    __device__ __forceinline__ void a_ready(const Unit&) const {}
    __device__ __forceinline__ void done(const Unit&) const {}
};

template <class Epi, class Sched, bool ALIGN_EPI = false, bool SP2 = false>
__device__ __forceinline__ void gemm_phase(PG8_LAS unsigned char* lds, const Gemm g, const Sched& S, const Epi& E) {
    const int tid = threadIdx.x, wid = __builtin_amdgcn_readfirstlane(tid >> 6), lane = tid & 63, wr = wid >> 2, wc = wid & 3, fr = lane & 15, fq = lane >> 4;
    const int K = g.K, nt = K / BK;
    unsigned voffA[2], voffB[2];
#pragma unroll
    for (int i = 0; i < 2; ++i) { int R, C; stage_rc(tid * 16 + i * 8192, R, C); const int Rb = Epi::PERM ? ((R & ~31) + perm32(R & 31)) : R;
        voffA[i] = (unsigned)(R * K + C) * 2u; voffB[i] = (unsigned)(Rb * K + C) * 2u; }
    const size_t kstep = (size_t)(BK * 2);
    const size_t hstep = (size_t)HALF * K * 2;
    const size_t tstep = 2 * hstep;
    const unsigned ldsw = (unsigned)wid * 1024u;
    const int aoff = lds_byte(wr * 64 + fr, fq * 8), boff = lds_byte(wc * 32 + fr, fq * 8);
#define PG8_SA(b, h) (((b) * 2 + (h)) * HTB)
#define PG8_SB(b, h) ((4 + (b) * 2 + (h)) * HTB)
#define PG8_STAGE(bufoff, gbase, voff) do { _Pragma("unroll") for (int _i = 0; _i < 2; ++_i) \
        __builtin_amdgcn_global_load_lds((const unsigned*)((const char*)(gbase) + (voff)[_i]), (PG8_LAS unsigned*)(lds + (bufoff) + ldsw + _i * 8192), 16, 0, 0); } while (0)
#define PG8_LDA(dst, b, h) do { _Pragma("unroll") for (int m = 0; m < 4; ++m) _Pragma("unroll") for (int k = 0; k < 2; ++k) dst[m][k] = *(const PG8_LAS bf16x8*)(lds + PG8_SA(b, h) + aoff + m * 2048 + k * 1024); } while (0)
#define PG8_LDB(dst, b, h) do { _Pragma("unroll") for (int n = 0; n < 2; ++n) _Pragma("unroll") for (int k = 0; k < 2; ++k) dst[n][k] = *(const PG8_LAS bf16x8*)(lds + PG8_SB(b, h) + boff + n * 2048 + k * 1024); } while (0)
#define PG8_MMA(ai, bj, At, Bt) do { __builtin_amdgcn_s_setprio(1); _Pragma("unroll") for (int m = 0; m < 4; ++m) _Pragma("unroll") for (int n = 0; n < 2; ++n) _Pragma("unroll") for (int k = 0; k < 2; ++k) \
        acc[ai][bj][m][n] = __builtin_amdgcn_mfma_f32_16x16x32_bf16(Bt[n][k], At[m][k], acc[ai][bj][m][n], 0, 0, 0); __builtin_amdgcn_s_setprio(0); } while (0)
#define PG8_WAIT_V(n) asm volatile("s_waitcnt vmcnt(" #n ")" ::: "memory")
#define PG8_WAIT_L(n) asm volatile("s_waitcnt lgkmcnt(" #n ")" ::: "memory")
#define PG8_BAR __builtin_amdgcn_s_barrier()
#define PG8_SCHED __builtin_amdgcn_sched_barrier(0)
    Unit cur, nxt; int ui = 0;
    if (!S.next(0, cur)) return;
    f32x4 acc[2][2][4][2];
#pragma unroll
    for (int a = 0; a < 2; ++a)
#pragma unroll
        for (int b = 0; b < 2; ++b)
#pragma unroll
            for (int m = 0; m < 4; ++m)
#pragma unroll
                for (int n = 0; n < 2; ++n) acc[a][b][m][n] = (f32x4){0.f, 0.f, 0.f, 0.f};
    bf16x8 At[4][2], B0[2][2], B1[2][2];
    const char* cA = (const char*)g.A + (size_t)cur.pm * tstep; const char* cB = (const char*)g.Bt + (size_t)cur.pn * tstep;
    S.a_ready(cur);
    if constexpr (SP2) {
        PG8_STAGE(PG8_SB(0, 0), cB, voffB); PG8_STAGE(PG8_SB(0, 1), cB + hstep, voffB); PG8_STAGE(PG8_SA(0, 0), cA, voffA); PG8_STAGE(PG8_SA(0, 1), cA + hstep, voffA);
        if (wr == 1) PG8_BAR;
        PG8_WAIT_V(2); PG8_BAR;
        PG8_STAGE(PG8_SB(1, 0), cB + kstep, voffB); PG8_STAGE(PG8_SA(1, 0), cA + kstep, voffA); PG8_STAGE(PG8_SB(1, 1), cB + hstep + kstep, voffB);
        PG8_WAIT_V(6); PG8_BAR;
    } else {
        PG8_STAGE(PG8_SB(0, 0), cB, voffB); PG8_STAGE(PG8_SA(0, 0), cA, voffA); PG8_STAGE(PG8_SB(0, 1), cB + hstep, voffB); PG8_STAGE(PG8_SA(0, 1), cA + hstep, voffA);
        if (wr == 1) PG8_BAR;
        PG8_WAIT_V(4); PG8_BAR;
        PG8_STAGE(PG8_SB(1, 0), cB + kstep, voffB); PG8_STAGE(PG8_SA(1, 0), cA + kstep, voffA); PG8_STAGE(PG8_SB(1, 1), cB + hstep + kstep, voffB);
        PG8_WAIT_V(6); PG8_BAR;
    }
    for (;;) {
        const bool has_next = S.next(ui + 1, nxt);
        const char* nA = has_next ? (const char*)g.A + (size_t)nxt.pm * tstep : cA; const char* nB = has_next ? (const char*)g.Bt + (size_t)nxt.pn * tstep : cB;
        for (int t = 0; t < nt; t += 2) {
            const bool last = (t == nt - 2);
            const char* a1 = cA + (size_t)(t + 1) * kstep;
            const char* a2 = last ? nA : cA + (size_t)(t + 2) * kstep; const char* b2 = last ? nB : cB + (size_t)(t + 2) * kstep;
            const char* a3 = a2 + kstep; const char* b3 = b2 + kstep;
            if (last && has_next) S.a_ready(nxt);
            if constexpr (SP2) {
            PG8_LDB(B0, 0, 0); PG8_LDB(B1, 0, 1); PG8_SCHED; PG8_LDA(At, 0, 0); PG8_STAGE(PG8_SA(1, 1), a1 + hstep, voffA);
            PG8_WAIT_V(8); PG8_WAIT_L(0); PG8_BAR; PG8_MMA(0, 0, At, B0); PG8_MMA(0, 1, At, B1); PG8_BAR; PG8_SCHED;
            PG8_LDA(At, 0, 1); PG8_STAGE(PG8_SB(0, 0), b2, voffB); PG8_STAGE(PG8_SB(0, 1), b2 + hstep, voffB); PG8_STAGE(PG8_SA(0, 0), a2, voffA);
            PG8_WAIT_V(8); PG8_WAIT_L(0); PG8_BAR; PG8_MMA(1, 0, At, B0); PG8_MMA(1, 1, At, B1); PG8_BAR; PG8_SCHED;
            PG8_LDB(B0, 1, 0); PG8_LDB(B1, 1, 1); PG8_SCHED; PG8_LDA(At, 1, 0); PG8_STAGE(PG8_SA(0, 1), a2 + hstep, voffA);
            PG8_WAIT_V(8); PG8_WAIT_L(0); PG8_BAR; PG8_MMA(0, 0, At, B0); PG8_MMA(0, 1, At, B1); PG8_BAR; PG8_SCHED;
            PG8_LDA(At, 1, 1); PG8_STAGE(PG8_SB(1, 0), b3, voffB); PG8_STAGE(PG8_SB(1, 1), b3 + hstep, voffB); PG8_STAGE(PG8_SA(1, 0), a3, voffA);
            PG8_WAIT_V(8); PG8_WAIT_L(0); PG8_BAR; PG8_MMA(1, 0, At, B0); PG8_MMA(1, 1, At, B1); PG8_BAR; PG8_SCHED;
            } else {
            PG8_LDB(B0, 0, 0); PG8_SCHED; PG8_LDA(At, 0, 0); PG8_STAGE(PG8_SA(1, 1), a1 + hstep, voffA);
            PG8_WAIT_L(8); PG8_BAR; PG8_WAIT_L(0); PG8_MMA(0, 0, At, B0); PG8_BAR; PG8_SCHED;
            PG8_LDB(B1, 0, 1); PG8_STAGE(PG8_SB(0, 0), b2, voffB);
            PG8_BAR; PG8_WAIT_L(0); PG8_MMA(0, 1, At, B1); PG8_BAR;
            PG8_LDA(At, 0, 1); PG8_STAGE(PG8_SA(0, 0), a2, voffA);
            PG8_BAR; PG8_WAIT_L(0); PG8_MMA(1, 0, At, B0); PG8_BAR; PG8_SCHED;
            PG8_STAGE(PG8_SB(0, 1), b2 + hstep, voffB);
            PG8_WAIT_V(6); PG8_BAR; PG8_MMA(1, 1, At, B1); PG8_BAR;
            PG8_LDB(B0, 1, 0); PG8_SCHED; PG8_LDA(At, 1, 0); PG8_STAGE(PG8_SA(0, 1), a2 + hstep, voffA);
            PG8_WAIT_L(8); PG8_BAR; PG8_WAIT_L(0); PG8_MMA(0, 0, At, B0); PG8_BAR; PG8_SCHED;
            PG8_LDB(B1, 1, 1); PG8_STAGE(PG8_SB(1, 0), b3, voffB);
            PG8_BAR; PG8_WAIT_L(0); PG8_MMA(0, 1, At, B1); PG8_BAR;
            PG8_LDA(At, 1, 1); PG8_STAGE(PG8_SA(1, 0), a3, voffA);
            PG8_BAR; PG8_WAIT_L(0); PG8_MMA(1, 0, At, B0); PG8_BAR; PG8_SCHED;
            PG8_STAGE(PG8_SB(1, 1), b3 + hstep, voffB);
            PG8_WAIT_V(6); PG8_BAR; PG8_MMA(1, 1, At, B1); PG8_BAR;
            }
        }
        if constexpr (ALIGN_EPI) { if (wr == 0) PG8_BAR; }
        if constexpr (!Epi::AFTER_DRAIN) { E(acc, cur, wr, wc, fr, fq); S.done(cur); }
        if (!has_next) break;
#pragma unroll
        for (int a = 0; a < 2; ++a)
#pragma unroll
            for (int b = 0; b < 2; ++b)
#pragma unroll
                for (int m = 0; m < 4; ++m)
#pragma unroll
                    for (int n = 0; n < 2; ++n) acc[a][b][m][n] = (f32x4){0.f, 0.f, 0.f, 0.f};
        cur = nxt; cA = nA; cB = nB; ++ui;
        if constexpr (ALIGN_EPI) { if (wr == 1) PG8_BAR; }
    }
    PG8_WAIT_V(0);
    if constexpr (!ALIGN_EPI) { if (wr == 0) PG8_BAR; }
    PG8_BAR;
    if constexpr (Epi::AFTER_DRAIN) { E.fused(acc, cur, wr, wc, fr, fq, lds, wid, lane); S.done(cur); }
#undef PG8_SA
#undef PG8_SB
#undef PG8_STAGE
#undef PG8_LDA
#undef PG8_LDB
#undef PG8_MMA
#undef PG8_WAIT_V
#undef PG8_WAIT_L
#undef PG8_BAR
#undef PG8_SCHED
}
}

template <int ACT  > struct EpiStore {
    static constexpr bool PERM = true, AFTER_DRAIN = false;
    bf16_t* O; int ldc; int split_col; bf16_t* O2; int ldc2;
    DI void operator()(const f32x4 (&acc)[2][2][4][2], const pg8::Unit& u, int wr, int wc, int fr, int fq) const {
        const int row0 = u.pm * 256 + wr * 64 + fr; int colt = u.pn * 256; bf16_t* base = O; int ld = ldc;
        if (colt >= split_col) { base = O2; colt -= split_col; ld = ldc2; }
        const int col0 = colt + wc * 32 + 8 * fq;
#pragma unroll
        for (int ai = 0; ai < 2; ++ai)
#pragma unroll
            for (int m = 0; m < 4; ++m) {
                bf16_t* rowp = base + (size_t)(row0 + ai * 128 + m * 16) * ld + col0;
#pragma unroll
                for (int bj = 0; bj < 2; ++bj) {
                    f32x4 v0 = acc[ai][bj][m][0], v1 = acc[ai][bj][m][1];
                    if (ACT == 1) {
#pragma unroll
                        for (int i = 0; i < 4; ++i) { const float a = fmaxf(v0[i], 0.f), b = fmaxf(v1[i], 0.f); v0[i] = a * a; v1[i] = b * b; }
                    }
                    u32x4 w = {pk2(v0[0], v0[1]), pk2(v0[2], v0[3]), pk2(v1[0], v1[1]), pk2(v1[2], v1[3])};
                    *(u32x4*)(rowp + bj * 128) = w;
                }
            }
    }
};
template <int ACT>
DI void run_gemm(unsigned char* lds, const bf16_t* A, const bf16_t* Bt, int M, int N, int K, bf16_t* O, int ldc, int split_col, bf16_t* O2, int ldc2) {
    pg8::Gemm g{A, Bt, M, N, K};
    pg8::StaticOrder S; S.init(M, N, (int)gridDim.x, (int)blockIdx.x);
    EpiStore<ACT> E{O, ldc, split_col, O2, ldc2};
    pg8::gemm_phase<EpiStore<ACT>, pg8::StaticOrder, true, true>((PG8_LAS unsigned char*)lds, g, S, E);
}

DI void skinny16(const bf16_t* __restrict__ A, const bf16_t* __restrict__ Bt16, float* __restrict__ BA, int wu, int lane) {
    const int fr = lane & 15, fq = lane >> 4, r0 = wu * 32;
    f32x4 a0 = {0.f, 0.f, 0.f, 0.f}, a1 = {0.f, 0.f, 0.f, 0.f};
    const bf16_t* ap0 = A + (size_t)(r0 + fr) * 1024 + fq * 8;
    const bf16_t* ap1 = ap0 + 16 * 1024;
    const bf16_t* bp = Bt16 + (size_t)fr * 1024 + fq * 8;
#pragma unroll 4
    for (int ks = 0; ks < 32; ++ks) {
        const bf16x8 b = *(const bf16x8*)(bp + ks * 32);
        a0 = mfma16(b, *(const bf16x8*)(ap0 + ks * 32), a0);
        a1 = mfma16(b, *(const bf16x8*)(ap1 + ks * 32), a1);
    }
    *(f32x4*)(BA + (size_t)(r0 + fr) * 16 + 4 * fq) = a0;
    *(f32x4*)(BA + (size_t)(r0 + 16 + fr) * 16 + 4 * fq) = a1;
}

DI void conv8(const bf16_t* __restrict__ proj, const float* __restrict__ convw, int b, int t, int cc, float* dst) {
    float acc[8];
#pragma unroll
    for (int i = 0; i < 8; ++i) acc[i] = 0.f;
#pragma unroll
    for (int dt = 0; dt < 4; ++dt) {
        const int tt = t - 3 + dt;
        u32x4 raw = {0u, 0u, 0u, 0u};
        if (tt >= 0) raw = *(const u32x4*)(proj + (size_t)(b * T_SEQ + tt) * 3072 + cc);
        const f32x4 w0 = *(const f32x4*)(convw + dt * 3072 + cc), w1 = *(const f32x4*)(convw + dt * 3072 + cc + 4);
        acc[0] += bflo(raw.x) * w0[0]; acc[1] += bfhi(raw.x) * w0[1]; acc[2] += bflo(raw.y) * w0[2]; acc[3] += bfhi(raw.y) * w0[3];
        acc[4] += bflo(raw.z) * w1[0]; acc[5] += bfhi(raw.z) * w1[1]; acc[6] += bflo(raw.w) * w1[2]; acc[7] += bfhi(raw.w) * w1[3];
    }
#pragma unroll
    for (int i = 0; i < 8; ++i) { float r = acc[i] / (1.f + __expf(-acc[i])); asm volatile("" : "+v"(r)); dst[i] = r; }
}

constexpr int P2_SQ = 0, P2_SK = 17408, P2_SQG = 34816, P2_SKGT = 52224, P2_SKGBT = 70656, P2_SVBT = 89088, P2_SL = 107520, P2_STB = 124928, P2_SG = 134144, P2_SGC = 134400, P2_SBETA = 134656;

DI void gdn_prep_chunk(unsigned char* lds, const bf16_t* __restrict__ proj, const float* __restrict__ BA, const float* __restrict__ convw,
                       const float* __restrict__ a_log, const float* __restrict__ dt_bias, unsigned char* __restrict__ frags, float* __restrict__ GL, int cid) {
    int tid_ = threadIdx.x; asm volatile("" : "+v"(tid_));
    const int tid = tid_, lane = tid & 63, wid = __builtin_amdgcn_readfirstlane(tid >> 6), fr = lane & 15, fq = lane >> 4;
    const int bh = cid >> 7, n = cid & 127, b = bh >> 3, h = bh & 7;
    float* sg = (float*)(lds + P2_SG); float* sgc = (float*)(lds + P2_SGC); float* sbeta = (float*)(lds + P2_SBETA);
    float* sL = (float*)(lds + P2_SL);
    unsigned char* fbase = frags + (size_t)cid * FRAG_CHUNK;
    const int row = tid >> 3, cg8 = tid & 7, t = n * 64 + row, grow = b * T_SEQ + t;
    float q[16], k[16], v[16];
    {
        const int c0 = h * 128 + cg8 * 16;
#define CBAR() asm volatile("" ::: "memory")
        conv8(proj, convw, b, t, c0, q); CBAR(); conv8(proj, convw, b, t, c0 + 8, q + 8); CBAR();
        conv8(proj, convw, b, t, 1024 + c0, k); CBAR(); conv8(proj, convw, b, t, 1024 + c0 + 8, k + 8); CBAR();
        conv8(proj, convw, b, t, 2048 + c0, v); CBAR(); conv8(proj, convw, b, t, 2048 + c0 + 8, v + 8); CBAR();
    }
    float sq = 0.f, sk = 0.f;
#pragma unroll
    for (int i = 0; i < 16; ++i) { sq += q[i] * q[i]; sk += k[i] * k[i]; }
    sq += __shfl_xor(sq, 1); sq += __shfl_xor(sq, 2); sq += __shfl_xor(sq, 4);
    sk += __shfl_xor(sk, 1); sk += __shfl_xor(sk, 2); sk += __shfl_xor(sk, 4);
    const float qs = rsqrtf(sq + EPS) * 0.08838834764831845f, ks_ = rsqrtf(sk + EPS);
    const float braw = BA[(size_t)grow * 16 + h], araw = BA[(size_t)grow * 16 + 8 + h];
    const float beta = 1.f / (1.f + expf(-braw));
    const float xsp = araw + dt_bias[h];
    const float gval = -expf(a_log[h]) * (fmaxf(xsp, 0.f) + log1pf(expf(-fabsf(xsp))));
    if (cg8 == 0) { sg[row] = gval; sbeta[row] = beta; }
    __syncthreads();
    if (wid == 0) {
        float x = sg[lane];
#pragma unroll
        for (int off = 1; off < 64; off <<= 1) { const float y = __shfl_up(x, off); if (lane >= off) x += y; }
        sgc[lane] = x;
    }
    __syncthreads();
    {
        const float gc = sgc[row], glast = sgc[63];
        const float ep = expf(gc), ek = expf(glast - gc);
        u32x4 w0, w1;
#define PK16(dst0, dst1, expr) do { float e_[16]; _Pragma("unroll") for (int i = 0; i < 16; ++i) e_[i] = (expr); \
        dst0 = (u32x4){pk2(e_[0], e_[1]), pk2(e_[2], e_[3]), pk2(e_[4], e_[5]), pk2(e_[6], e_[7])}; dst1 = (u32x4){pk2(e_[8], e_[9]), pk2(e_[10], e_[11]), pk2(e_[12], e_[13]), pk2(e_[14], e_[15])}; } while (0)
        PK16(w0, w1, q[i] * qs);
        *(u32x4*)(lds + P2_SQ + row * 272 + cg8 * 32) = w0; *(u32x4*)(lds + P2_SQ + row * 272 + cg8 * 32 + 16) = w1;
        PK16(w0, w1, k[i] * ks_);
        *(u32x4*)(lds + P2_SK + row * 272 + cg8 * 32) = w0; *(u32x4*)(lds + P2_SK + row * 272 + cg8 * 32 + 16) = w1;
        PK16(w0, w1, q[i] * (qs * ep));
        *(u32x4*)(lds + P2_SQG + row * 272 + cg8 * 32) = w0; *(u32x4*)(lds + P2_SQG + row * 272 + cg8 * 32 + 16) = w1;
        bf16_t* sKGT = (bf16_t*)(lds + P2_SKGT); bf16_t* sKGbT = (bf16_t*)(lds + P2_SKGBT); bf16_t* sVbT = (bf16_t*)(lds + P2_SVBT);
        const float kek = ks_ * ek, kbe = ks_ * beta * ep;
#pragma unroll
        for (int i = 0; i < 16; i += 2) {
            const int d = cg8 * 16 + i;
            const unsigned a = pk2(k[i] * kek, k[i + 1] * kek), bb = pk2(k[i] * kbe, k[i + 1] * kbe), c = pk2(v[i] * beta, v[i + 1] * beta);
            sKGT[d * 72 + row] = (bf16_t)(a & 0xffff); sKGT[(d + 1) * 72 + row] = (bf16_t)(a >> 16);
            sKGbT[d * 72 + row] = (bf16_t)(bb & 0xffff); sKGbT[(d + 1) * 72 + row] = (bf16_t)(bb >> 16);
            sVbT[d * 72 + row] = (bf16_t)(c & 0xffff); sVbT[(d + 1) * 72 + row] = (bf16_t)(c >> 16);
        }
        if (tid == 0) GL[cid] = expf(glast);
    }
    __syncthreads();
    {
        const int mi = wid & 3, kc = wid >> 2;
        f32x4 a0 = {0.f, 0.f, 0.f, 0.f}, a1 = {0.f, 0.f, 0.f, 0.f};
#pragma unroll
        for (int ks = 0; ks < 4; ++ks) {
            const bf16x8 qb = *(const bf16x8*)(lds + P2_SQ + (16 * mi + fr) * 272 + ks * 64 + fq * 16);
            const bf16x8 k0 = *(const bf16x8*)(lds + P2_SK + (32 * kc + fr) * 272 + ks * 64 + fq * 16);
            const bf16x8 k1 = *(const bf16x8*)(lds + P2_SK + (32 * kc + 16 + fr) * 272 + ks * 64 + fq * 16);
            a0 = mfma16(k0, qb, a0); a1 = mfma16(k1, qb, a1);
        }
        const int c = 16 * mi + fr; const float gcc = sgc[c];
        f32x4 v0, v1;
#pragma unroll
        for (int r = 0; r < 4; ++r) {
            const int c0 = 32 * kc + 4 * fq + r, c1 = c0 + 16;
            v0[r] = (c >= c0) ? a0[r] * expf(gcc - sgc[c0]) : 0.f;
            v1[r] = (c >= c1) ? a1[r] * expf(gcc - sgc[c1]) : 0.f;
        }
        *(bf16x8*)(fbase + 49152 + ((mi * 2 + kc) * 64 + lane) * 16) = pack8(v0, v1);
        const int it = wid & 3;
#pragma unroll
        for (int jj = 0; jj < 2; ++jj) {
            const int jt = (wid >> 2) * 2 + jj;
            f32x4 acc = {0.f, 0.f, 0.f, 0.f};
#pragma unroll
            for (int ks = 0; ks < 4; ++ks) {
                const bf16x8 ka = *(const bf16x8*)(lds + P2_SK + (16 * it + fr) * 272 + ks * 64 + fq * 16);
                const bf16x8 kb = *(const bf16x8*)(lds + P2_SK + (16 * jt + fr) * 272 + ks * 64 + fq * 16);
                acc = mfma16(ka, kb, acc);
            }
            const int j = 16 * jt + fr; const float gcj = sgc[j];
#pragma unroll
            for (int r = 0; r < 4; ++r) {
                const int i = 16 * it + 4 * fq + r;
                sL[i * 68 + j] = (i > j) ? sbeta[i] * acc[r] * expf(sgc[i] - gcj) : 0.f;
            }
        }
    }
    __syncthreads();
    if (wid == 0) {
        bf16_t* sTb = (bf16_t*)(lds + P2_STB);
        int vz = 0; asm volatile("" : "+v"(vz));
        const float* sLv = sL + vz;
        float x[64];
#pragma unroll
        for (int i = 0; i < 64; ++i) x[i] = 0.f;
#pragma unroll
        for (int i = 0; i < 64; ++i) {
            float a0 = -sL[i * 68 + lane], a1 = 0.f;
#pragma unroll
            for (int mb = 0; mb * 4 < i; ++mb) {
                const f32x4 Lv = *(const f32x4*)(sLv + i * 68 + mb * 4);
                if (mb & 1) { a1 -= Lv[0] * x[4 * mb]; a1 -= Lv[1] * x[4 * mb + 1]; a1 -= Lv[2] * x[4 * mb + 2]; a1 -= Lv[3] * x[4 * mb + 3]; }
                else        { a0 -= Lv[0] * x[4 * mb]; a0 -= Lv[1] * x[4 * mb + 1]; a0 -= Lv[2] * x[4 * mb + 2]; a0 -= Lv[3] * x[4 * mb + 3]; }
            }
            x[i] = a0 + a1;
            sTb[i * 72 + lane] = (bf16_t)(pk2(x[i], 0.f) & 0xffff);
        }
        LDS_WAIT();
        sTb[lane * 72 + lane] = (bf16_t)0x3F80;
    } else {
        for (int slot = tid - 64; slot < 2048; slot += 448) {
            const int f = slot >> 6, l = slot & 63, m = l & 15, g = l >> 4;
            const unsigned char* src; unsigned char* dst;
            if (f < 16) { const int mi = f >> 2, kb = f & 3; src = lds + P2_SQG + (16 * mi + m) * 272 + (32 * kb + 4 * g) * 2; dst = fbase + 16384 + slot * 16; }
            else { const int f2 = f - 16, tt = f2 >> 1, kc = f2 & 1; src = lds + P2_SKGT + (16 * tt + m) * 144 + (32 * kc + 4 * g) * 2; dst = fbase + 32768 + (slot - 1024) * 16; }
            const u32x2 lo = *(const u32x2*)src, hi = *(const u32x2*)(src + 32);
            *(u32x4*)dst = (u32x4){lo.x, lo.y, hi.x, hi.y};
        }
    }
    __syncthreads();
    {
        const int mi = wid & 3;
#pragma unroll
        for (int kk = 0; kk < 2; ++kk) {
            const int kb = (wid >> 2) * 2 + kk;
            f32x4 d0 = {0.f, 0.f, 0.f, 0.f}, d1 = {0.f, 0.f, 0.f, 0.f};
#pragma unroll
            for (int ks = 0; ks < 2; ++ks) {
                const bf16x8 tb = *(const bf16x8*)(lds + P2_STB + (16 * mi + fr) * 144 + ks * 64 + fq * 16);
                const bf16x8 g0 = *(const bf16x8*)(lds + P2_SKGBT + (32 * kb + fr) * 144 + ks * 64 + fq * 16);
                const bf16x8 g1 = *(const bf16x8*)(lds + P2_SKGBT + (32 * kb + 16 + fr) * 144 + ks * 64 + fq * 16);
                d0 = mfma16(g0, tb, d0); d1 = mfma16(g1, tb, d1);
            }
            *(bf16x8*)(fbase + ((mi * 4 + kb) * 64 + lane) * 16) = pack8(d0, d1);
        }
#pragma unroll
        for (int q4 = 0; q4 < 4; ++q4) {
            const int dvt = (wid >> 2) * 4 + q4;
            f32x4 u = {0.f, 0.f, 0.f, 0.f};
#pragma unroll
            for (int ks = 0; ks < 2; ++ks) {
                const bf16x8 ta = *(const bf16x8*)(lds + P2_STB + (16 * mi + fr) * 144 + ks * 64 + fq * 16);
                const bf16x8 vb = *(const bf16x8*)(lds + P2_SVBT + (16 * dvt + fr) * 144 + ks * 64 + fq * 16);
                u = mfma16(ta, vb, u);
            }
            u32x2 o = {pk2(u[0], u[1]), pk2(u[2], u[3])};
            *(u32x2*)(fbase + 57344 + dvt * 2048 + mi * 512 + lane * 8) = o;
        }
    }
    __syncthreads();
}

constexpr int P3_STEP = 59392;
DI void gdn_scan(unsigned char* lds, const unsigned char* __restrict__ frags, const float* __restrict__ GL, float* __restrict__ O, int item) {
    const int tid = threadIdx.x, lane = tid & 63, wid = tid >> 6, fr = lane & 15, fq = lane >> 4;
    const int bh = item >> 3, slice = item & 7, b = bh >> 3, h = bh & 7;
    float* sGL = (float*)(lds + 2 * P3_STEP);
    if (tid < 128) sGL[tid] = GL[bh * 128 + tid];
    const int lt = tid - 64;
    u32x4 rg[9];
    auto issue = [&](int n) {
        const unsigned char* src = frags + (size_t)(bh * 128 + n) * FRAG_CHUNK;
#pragma unroll
        for (int i = 0; i < 9; ++i) {
            const int qq = lt + 448 * i;
            if (qq < 3712) rg[i] = *(const u32x4*)(qq < 3584 ? src + qq * 16 : src + 57344 + slice * 2048 + (qq - 3584) * 16);
        }
    };
    auto commit = [&](int buf) {
        unsigned char* dst = lds + buf * P3_STEP;
#pragma unroll
        for (int i = 0; i < 9; ++i) { const int qq = lt + 448 * i; if (qq < 3712) *(u32x4*)(dst + qq * 16) = rg[i]; }
    };
    if (wid > 0) { issue(0); commit(0); issue(1); }
    f32x4 S[8];
#pragma unroll
    for (int t = 0; t < 8; ++t) S[t] = (f32x4){0.f, 0.f, 0.f, 0.f};
    __syncthreads();
    for (int n = 0; n < 128; ++n) {
        if (wid > 0) {
            if (n + 1 < 128) commit((n + 1) & 1);
            if (n + 2 < 128) issue(n + 2);
        } else {
            const unsigned char* Bf = lds + (n & 1) * P3_STEP;
            const float gl = sGL[n];
            bf16x8 Sb[4];
#pragma unroll
            for (int kb = 0; kb < 4; ++kb) Sb[kb] = pack8(S[2 * kb], S[2 * kb + 1]);
            f32x4 P[4], Oa[4];
#pragma unroll
            for (int mi = 0; mi < 4; ++mi) { P[mi] = (f32x4){0.f, 0.f, 0.f, 0.f}; Oa[mi] = (f32x4){0.f, 0.f, 0.f, 0.f}; }
#pragma unroll
            for (int kb = 0; kb < 4; ++kb)
#pragma unroll
                for (int mi = 0; mi < 4; ++mi) {
                    P[mi] = mfma16(*(const bf16x8*)(Bf + ((mi * 4 + kb) * 64 + lane) * 16), Sb[kb], P[mi]);
                    Oa[mi] = mfma16(*(const bf16x8*)(Bf + 16384 + ((mi * 4 + kb) * 64 + lane) * 16), Sb[kb], Oa[mi]);
                }
            f32x4 vn[4];
#pragma unroll
            for (int mi = 0; mi < 4; ++mi) {
                const u32x2 ur = *(const u32x2*)(Bf + 57344 + mi * 512 + lane * 8);
                vn[mi] = (f32x4){bflo(ur.x), bfhi(ur.x), bflo(ur.y), bfhi(ur.y)} - P[mi];
            }
            bf16x8 Vb[2];
            Vb[0] = pack8(vn[0], vn[1]); Vb[1] = pack8(vn[2], vn[3]);
#pragma unroll
            for (int kc = 0; kc < 2; ++kc)
#pragma unroll
                for (int mi = 0; mi < 4; ++mi) Oa[mi] = mfma16(*(const bf16x8*)(Bf + 49152 + ((mi * 2 + kc) * 64 + lane) * 16), Vb[kc], Oa[mi]);
#pragma unroll
            for (int t = 0; t < 8; ++t) S[t] = S[t] * gl;
#pragma unroll
            for (int kc = 0; kc < 2; ++kc)
#pragma unroll
                for (int t = 0; t < 8; ++t) S[t] = mfma16(*(const bf16x8*)(Bf + 32768 + ((t * 2 + kc) * 64 + lane) * 16), Vb[kc], S[t]);
            float* op = O + ((size_t)(b * T_SEQ + n * 64 + 4 * fq)) * 1024 + h * 128 + slice * 16 + fr;
#pragma unroll
            for (int mi = 0; mi < 4; ++mi)
#pragma unroll
                for (int r = 0; r < 4; ++r) op[(size_t)(16 * mi + r) * 1024] = Oa[mi][r];
        }
        __syncthreads();
    }
}

DI void gated_norm(const float* __restrict__ O, const bf16_t* __restrict__ gate, const float* __restrict__ out_gain, bf16_t* __restrict__ ON, int gw, int ngw, int lane) {
    f32x4 gn[4];
#pragma unroll
    for (int j = 0; j < 4; ++j) gn[j] = *(const f32x4*)(out_gain + ((lane & 7) * 16) + 4 * j);
    for (int row = gw; row < MTOK; row += ngw) {
        f32x4 o[4]; float ss = 0.f;
#pragma unroll
        for (int j = 0; j < 4; ++j) { o[j] = *(const f32x4*)(O + (size_t)row * 1024 + lane * 16 + 4 * j); ss += (o[j][0] * o[j][0] + o[j][1] * o[j][1]) + (o[j][2] * o[j][2] + o[j][3] * o[j][3]); }
        ss += __shfl_xor(ss, 1); ss += __shfl_xor(ss, 2); ss += __shfl_xor(ss, 4);
        const float rs = rsqrtf(ss * (1.f / 128.f) + EPS);
        const u32x4 g0 = *(const u32x4*)(gate + (size_t)row * 1024 + lane * 16), g1 = *(const u32x4*)(gate + (size_t)row * 1024 + lane * 16 + 8);
        float gv[16] = {bflo(g0.x), bfhi(g0.x), bflo(g0.y), bfhi(g0.y), bflo(g0.z), bfhi(g0.z), bflo(g0.w), bfhi(g0.w),
                        bflo(g1.x), bfhi(g1.x), bflo(g1.y), bfhi(g1.y), bflo(g1.z), bfhi(g1.z), bflo(g1.w), bfhi(g1.w)};
        float r[16];
#pragma unroll
        for (int i = 0; i < 16; ++i) { const float g = gv[i]; r[i] = o[i >> 2][i & 3] * rs * gn[i >> 2][i & 3] * (g / (1.f + __expf(-g))); }
        u32x4 w0 = {pk2(r[0], r[1]), pk2(r[2], r[3]), pk2(r[4], r[5]), pk2(r[6], r[7])}, w1 = {pk2(r[8], r[9]), pk2(r[10], r[11]), pk2(r[12], r[13]), pk2(r[14], r[15])};
        *(u32x4*)(ON + (size_t)row * 1024 + lane * 16) = w0; *(u32x4*)(ON + (size_t)row * 1024 + lane * 16 + 8) = w1;
    }
}

constexpr int SB_BUF = 35840, SB_SV = 17408;
DI void sb_attn_block(unsigned char* lds, const bf16_t* __restrict__ QK, const bf16_t* __restrict__ VT, bf16_t* __restrict__ ATT, int task) {
    int tid_ = threadIdx.x; asm volatile("" : "+v"(tid_));
    const int tid = tid_, lane = tid & 63, wid = __builtin_amdgcn_readfirstlane(tid >> 6), fr = lane & 15, fq = lane >> 4;
    const int qb = task & 63, bh = task >> 6, b = bh >> 3, h = bh & 7;
    const int t0 = qb * 128, tw = t0 + wid * 16, tq = tw + fr;
    const size_t rowbase = (size_t)b * T_SEQ;
    bf16x8 qf[4];
    {
        const bf16_t* qp = QK + (rowbase + tq) * 2048 + h * 128 + fq * 8;
#pragma unroll
        for (int ks = 0; ks < 4; ++ks) qf[ks] = *(const bf16x8*)(qp + ks * 32);
    }
    f32x4 oacc[8];
#pragma unroll
    for (int d = 0; d < 8; ++d) oacc[d] = (f32x4){0.f, 0.f, 0.f, 0.f};
    float carry = 0.f;
    const float scale = 0.08838834764831845f;
    const bf16_t* ksrc[2]; const bf16_t* vsrc[2]; int kdst[2], vdst[2];
#pragma unroll
    for (int i = 0; i < 2; ++i) {
        const int q = tid + 512 * i;
        const int krow = q >> 4, kc = q & 15; ksrc[i] = QK + (rowbase + krow) * 2048 + 1024 + h * 128 + kc * 8; kdst[i] = krow * 272 + kc * 16;
        const int vrow = q >> 3, vc = q & 7; vsrc[i] = VT + ((size_t)h * 128 + vrow) * MTOK + rowbase + vc * 8; vdst[i] = SB_SV + vrow * 144 + vc * 16;
    }
    u32x4 rk[2], rv[2];
    int kt = (t0 >> 6) + 1;
#pragma unroll
    for (int i = 0; i < 2; ++i) { rk[i] = *(const u32x4*)(ksrc[i] + (size_t)kt * 64 * 2048); rv[i] = *(const u32x4*)(vsrc[i] + kt * 64); }
#pragma unroll
    for (int i = 0; i < 2; ++i) { *(u32x4*)(lds + kdst[i]) = rk[i]; *(u32x4*)(lds + vdst[i]) = rv[i]; }
    __syncthreads();
    for (int it = 0;; ++it, --kt) {
        const bool more = kt > 0;
        if (more) {
#pragma unroll
            for (int i = 0; i < 2; ++i) { rk[i] = *(const u32x4*)(ksrc[i] + (size_t)(kt - 1) * 64 * 2048); rv[i] = *(const u32x4*)(vsrc[i] + (kt - 1) * 64); }
        }
        const int s0 = kt * 64;
        if (s0 < tw + 15) {
            const unsigned char* sK = lds + (it & 1) * SB_BUF;
            const unsigned char* sV = sK + SB_SV;
            f32x4 z[4];
#pragma unroll
            for (int j = 0; j < 4; ++j) {
                z[j] = (f32x4){0.f, 0.f, 0.f, 0.f};
#pragma unroll
                for (int ks = 0; ks < 4; ++ks) z[j] = mfma16(*(const bf16x8*)(sK + (16 * j + fr) * 272 + ks * 64 + fq * 16), qf[ks], z[j]);
            }
            f32x4 lb[4], lm[4]; float TT[4], E[4];
#pragma unroll
            for (int j = 0; j < 4; ++j) {
                float Tj = 0.f;
#pragma unroll
                for (int r = 0; r < 4; ++r) {
                    const int s = s0 + 16 * j + 4 * fq + r;
                    const float zz = z[j][r] * scale;
                    const float sp = fmaxf(-zz, 0.f) + __logf(1.f + __expf(-fabsf(zz)));
                    lb[j][r] = -sp;
                    const float m_ = (s < tq) ? (-sp - zz) : 0.f;
                    lm[j][r] = m_; Tj += m_;
                }
                const float b_ = __shfl_xor(Tj, 16); const float c_ = Tj + b_; const float d_ = __shfl_xor(c_, 32);
                TT[j] = c_ + d_;
                E[j] = ((fq & 1) ? 0.f : b_) + ((fq & 2) ? 0.f : d_);
            }
            f32x4 a[4];
            float later = carry;
#pragma unroll
            for (int j = 3; j >= 0; --j) {
                float suf = 0.f;
#pragma unroll
                for (int r = 3; r >= 0; --r) {
                    const int s = s0 + 16 * j + 4 * fq + r;
                    const float tail = suf + E[j] + later;
                    a[j][r] = (s < tq) ? __expf(lb[j][r] + tail) : 0.f;
                    suf += lm[j][r];
                }
                later += TT[j];
            }
            carry = later;
            bf16x8 ab[2];
            ab[0] = pack8(a[0], a[1]); ab[1] = pack8(a[2], a[3]);
#pragma unroll
            for (int dt = 0; dt < 8; ++dt)
#pragma unroll
                for (int kc = 0; kc < 2; ++kc) {
                    const unsigned char* vp = sV + (16 * dt + fr) * 144 + (32 * kc + 4 * fq) * 2;
                    oacc[dt] = mfma16(mk8(*(const u32x2*)vp, *(const u32x2*)(vp + 32)), ab[kc], oacc[dt]);
                }
        }
        if (more) {
            unsigned char* d = lds + ((it + 1) & 1) * SB_BUF;
#pragma unroll
            for (int i = 0; i < 2; ++i) { *(u32x4*)(d + kdst[i]) = rk[i]; *(u32x4*)(d + vdst[i]) = rv[i]; }
        }
        unsigned* flg = (unsigned*)(lds + 2 * SB_BUF) + (it & 1) * 8;
        const int wdone = __all(carry < -120.f);
        if (lane == 0) flg[wid] = (unsigned)wdone;
        __syncthreads();
        const u32x4 f0 = *(const u32x4*)flg, f1 = *(const u32x4*)(flg + 4);
        const bool alldone = (f0.x & f0.y & f0.z & f0.w & f1.x & f1.y & f1.z & f1.w) != 0u;
        if (!more || alldone) break;
    }
    bf16_t* op = ATT + (rowbase + tq) * 1024 + h * 128 + 4 * fq;
#pragma unroll
    for (int dt = 0; dt < 8; ++dt) { u32x2 o = {pk2(oacc[dt][0], oacc[dt][1]), pk2(oacc[dt][2], oacc[dt][3])}; *(u32x2*)(op + 16 * dt) = o; }
}

__global__ void __launch_bounds__(512) yoco_fwd(Params p) {
    extern __shared__ __attribute__((aligned(16))) unsigned char lds[];
    cg::grid_group grid = cg::this_grid();
    const int tid = threadIdx.x, lane = tid & 63, wid = __builtin_amdgcn_readfirstlane(tid >> 6);
    const int G = gridDim.x;
    const int vcu = ((G & 7) == 0) ? ((blockIdx.x & 7) * (G >> 3) + (blockIdx.x >> 3)) : blockIdx.x;
    const int gw = vcu * 8 + wid, ngw = G * 8;
    unsigned char* ws = p.ws;
    unsigned char* dob = (unsigned char*)p.out;
    const float* x = p.in[0];
    float* scr = (float*)(lds + wid * 8448);
    if (tid < 4) ((unsigned*)(lds + 147440))[tid] = 0u;
    __syncthreads();
    const XcdBarrier xb = xcd_barrier_post((unsigned*)(ws + WS_BAR), (volatile LAS unsigned*)(lds + 147440));

    for (int rep_ = 0; rep_ < 1 + (int)((PHREP >> 0) & 1u); ++rep_)
    {
        bf16_t* WTIN = (bf16_t*)(dob + DO_WTIN); bf16_t* WTOUT0 = (bf16_t*)(dob + DO_WTOUT0);
        const int I_IN = 16 * 129, I_OUT = 16 * 32;
        for (int it = gw; it < I_IN + I_OUT; it += ngw) {
            if (it < I_IN) transpose_item(p.in[7], 4112, 0, 4112, 1024, p.in[1], WTIN, scr, it, lane);
            else transpose_item(p.in[12], 1024, 0, 1024, 1024, nullptr, WTOUT0, scr, it - I_IN, lane);
        }
        row_pass<0>(x, nullptr, nullptr, nullptr, (bf16_t*)(ws + WS_H0), gw, ngw, lane);
    }
    grid.sync();
#ifdef SYNCREP
    for (int i_ = 0; i_ < SYNCREP; ++i_) xcd_barrier(xb);
#endif
    for (int rep_ = 0; rep_ < 1 + (int)((PHREP >> 1) & 1u); ++rep_)
    {
        run_gemm<0>(lds, (const bf16_t*)(ws + WS_H0), (const bf16_t*)(dob + DO_WTIN), MTOK, 4096, 1024, (bf16_t*)(ws + WS_PROJ), 3072, 3072, (bf16_t*)(dob + DO_GATE), 1024);
        if (wid < 2) { const int wu = vcu * 2 + wid; if (wu < 512) skinny16((const bf16_t*)(ws + WS_H0), (const bf16_t*)(dob + DO_WTIN) + (size_t)4096 * 1024, (float*)(dob + DO_BA), wu, lane); }
    }
    xcd_barrier(xb);
    for (int rep_ = 0; rep_ < 1 + (int)((PHREP >> 2) & 1u); ++rep_)
    for (int cid = vcu; cid < 2048; cid += G)
        gdn_prep_chunk(lds, (const bf16_t*)(ws + WS_PROJ), (const float*)(dob + DO_BA), p.in[8], p.in[9], p.in[10], ws + WS_FRAGS, (float*)(dob + DO_GL), cid);
    xcd_barrier(xb);
    for (int rep_ = 0; rep_ < 1 + (int)((PHREP >> 3) & 1u); ++rep_)
    {
        int first, stride;
        if (G == 256) { const int xx = vcu >> 5, j = vcu & 31; first = (j < 16) ? xx * 16 + j : 128; stride = 128; }
        else { first = blockIdx.x; stride = G; }
        for (int item = first; item < 128; item += stride) { gdn_scan(lds, ws + WS_FRAGS, (const float*)(dob + DO_GL), (float*)(ws + WS_O32), item); __syncthreads(); }
    }
    xcd_barrier(xb);
    for (int rep_ = 0; rep_ < 1 + (int)((PHREP >> 4) & 1u); ++rep_)
    {
        gated_norm((const float*)(ws + WS_O32), (const bf16_t*)(dob + DO_GATE), p.in[11], (bf16_t*)(ws + WS_ON), gw, ngw, lane);
        const int I0 = 2048, I1 = I0 + 2048, I2 = I1 + 512, I3 = I2 + 1024, I4 = I3 + 512, I5 = I4 + 2048, I6 = I5 + 2048;
        for (int it = gw; it < I6; it += ngw) {
            if (it < I0) transpose_item(p.in[5], 4096, 0, 4096, 1024, p.in[3], (bf16_t*)(ws + WS_WUP0), scr, it, lane);
            else if (it < I1) transpose_item(p.in[6], 1024, 0, 1024, 4096, nullptr, (bf16_t*)(ws + WS_WDN0), scr, it - I0, lane);
            else if (it < I2) transpose_item(p.in[15], 1024, 0, 1024, 1024, p.in[1] + 1024, (bf16_t*)(ws + WS_WQKV), scr, it - I1, lane);
            else if (it < I3) transpose_item(p.in[14], 2048, 0, 2048, 1024, p.in[13], (bf16_t*)(ws + WS_WQKV) + (size_t)1024 * 1024, scr, it - I2, lane);
            else if (it < I4) transpose_item(p.in[16], 1024, 0, 1024, 1024, nullptr, (bf16_t*)(ws + WS_WO1), scr, it - I3, lane);
            else if (it < I5) transpose_item(p.in[5] + (size_t)1024 * 4096, 4096, 0, 4096, 1024, p.in[3] + 1024, (bf16_t*)(ws + WS_WUP1), scr, it - I4, lane);
            else transpose_item(p.in[6] + (size_t)4096 * 1024, 1024, 0, 1024, 4096, nullptr, (bf16_t*)(ws + WS_WDN1), scr, it - I5, lane);
        }
    }
    xcd_barrier(xb);
    for (int rep_ = 0; rep_ < 1 + (int)((PHREP >> 5) & 1u); ++rep_)
    run_gemm<0>(lds, (const bf16_t*)(ws + WS_ON), (const bf16_t*)(dob + DO_WTOUT0), MTOK, 1024, 1024, (bf16_t*)(ws + WS_MIX_A), 1024, 1 << 30, nullptr, 0);
    xcd_barrier(xb);
    for (int rep_ = 0; rep_ < 1 + (int)((PHREP >> 6) & 1u); ++rep_)
    row_pass<1>(x, (const bf16_t*)(ws + WS_MIX_A), p.in[2], p.out, (bf16_t*)(ws + 0), gw, ngw, lane);
    xcd_barrier(xb);
    for (int rep_ = 0; rep_ < 1 + (int)((PHREP >> 7) & 1u); ++rep_)
    run_gemm<1>(lds, (const bf16_t*)(ws + 0), (const bf16_t*)(ws + WS_WUP0), MTOK, 4096, 1024, (bf16_t*)(ws + WS_UP), 4096, 1 << 30, nullptr, 0);
    xcd_barrier(xb);
    for (int rep_ = 0; rep_ < 1 + (int)((PHREP >> 8) & 1u); ++rep_)
    run_gemm<0>(lds, (const bf16_t*)(ws + WS_UP), (const bf16_t*)(ws + WS_WDN0), MTOK, 1024, 4096, (bf16_t*)(ws + 0), 1024, 1 << 30, nullptr, 0);
    xcd_barrier(xb);
    for (int rep_ = 0; rep_ < 1 + (int)((PHREP >> 9) & 1u); ++rep_)
    row_pass<1>(p.out, (const bf16_t*)(ws + 0), p.in[4], p.out, (bf16_t*)(ws + 32 * MiB), gw, ngw, lane);
    xcd_barrier(xb);
    for (int rep_ = 0; rep_ < 1 + (int)((PHREP >> 10) & 1u); ++rep_)
    {
        run_gemm<0>(lds, (const bf16_t*)(ws + 32 * MiB), (const bf16_t*)(ws + WS_WQKV), MTOK, 2048, 1024, (bf16_t*)(ws + WS_QK), 2048, 1 << 30, nullptr, 0);
        run_gemm<0>(lds, (const bf16_t*)(ws + WS_WQKV) + (size_t)2048 * 1024, (const bf16_t*)(ws + 32 * MiB), 1024, MTOK, 1024, (bf16_t*)(ws + WS_VT), MTOK, 1 << 30, nullptr, 0);
    }
    xcd_barrier(xb);
    for (int rep_ = 0; rep_ < 1 + (int)((PHREP >> 11) & 1u); ++rep_)
    for (int task = vcu; task < 1024; task += G) sb_attn_block(lds, (const bf16_t*)(ws + WS_QK), (const bf16_t*)(ws + WS_VT), (bf16_t*)(ws + 0), task);
    xcd_barrier(xb);
    for (int rep_ = 0; rep_ < 1 + (int)((PHREP >> 12) & 1u); ++rep_)
    run_gemm<0>(lds, (const bf16_t*)(ws + 0), (const bf16_t*)(ws + WS_WO1), MTOK, 1024, 1024, (bf16_t*)(ws + 32 * MiB), 1024, 1 << 30, nullptr, 0);
    xcd_barrier(xb);
    for (int rep_ = 0; rep_ < 1 + (int)((PHREP >> 13) & 1u); ++rep_)
    row_pass<1>(p.out, (const bf16_t*)(ws + 32 * MiB), p.in[2] + 1024, p.out, (bf16_t*)(ws + 0), gw, ngw, lane);
    xcd_barrier(xb);
    for (int rep_ = 0; rep_ < 1 + (int)((PHREP >> 14) & 1u); ++rep_)
    run_gemm<1>(lds, (const bf16_t*)(ws + 0), (const bf16_t*)(ws + WS_WUP1), MTOK, 4096, 1024, (bf16_t*)(ws + WS_UP), 4096, 1 << 30, nullptr, 0);
    xcd_barrier(xb);
    for (int rep_ = 0; rep_ < 1 + (int)((PHREP >> 15) & 1u); ++rep_)
    run_gemm<0>(lds, (const bf16_t*)(ws + WS_UP), (const bf16_t*)(ws + WS_WDN1), MTOK, 1024, 4096, (bf16_t*)(ws + 0), 1024, 1 << 30, nullptr, 0);
    xcd_barrier(xb);
    for (int rep_ = 0; rep_ < 1 + (int)((PHREP >> 16) & 1u); ++rep_)
    row_pass<2>(p.out, (const bf16_t*)(ws + 0), p.in[4] + 1024, p.out, nullptr, gw, ngw, lane);
}

extern "C" void kernel_launch(void* const* d_in, const int* in_sizes, int n_in, void* d_out, int out_size, void* d_ws, size_t ws_size, hipStream_t stream) {
    static int grid_blocks = 0;
    if (grid_blocks == 0) {
        if (n_in != 17 || out_size != MTOK * 1024 || ws_size < 256 * MiB) { fprintf(stderr, "kernel_launch: unexpected problem shape (n_in %d out %d ws %zu)\n", n_in, out_size, ws_size); grid_blocks = -1; return; }
        int dev = 0, cus = 0, per_cu = 0;
        hipGetDevice(&dev);
        hipDeviceGetAttribute(&cus, hipDeviceAttributeMultiprocessorCount, dev);
        if (hipFuncSetAttribute((const void*)yoco_fwd, hipFuncAttributeMaxDynamicSharedMemorySize, LDS_BYTES) != hipSuccess) { fprintf(stderr, "kernel_launch: hipFuncSetAttribute failed\n"); grid_blocks = -1; return; }
        hipOccupancyMaxActiveBlocksPerMultiprocessor(&per_cu, (const void*)yoco_fwd, 512, LDS_BYTES);
        if (per_cu < 1) { fprintf(stderr, "kernel_launch: occupancy query says %d blocks per CU\n", per_cu); per_cu = 1; }
        grid_blocks = cus * 1;
    }
    if (grid_blocks < 0) return;
    if (hipMemsetAsync((char*)d_ws + WS_BAR, 0, XCD_BAR_WORDS * 4, stream) != hipSuccess) { fprintf(stderr, "kernel_launch: memset of barrier words failed\n"); return; }
    Params p{};
    for (int i = 0; i < 17; ++i) p.in[i] = (const float*)d_in[i];
    p.out = (float*)d_out; p.ws = (unsigned char*)d_ws;
    void* args[] = {&p};
    hipError_t e = hipLaunchCooperativeKernel((const void*)yoco_fwd, dim3(grid_blocks), dim3(512), args, LDS_BYTES, stream);
    if (e != hipSuccess) fprintf(stderr, "cooperative launch failed: %s (grid %d)\n", hipGetErrorString(e), grid_blocks);
}
```

```cpp
#include <hip/hip_runtime.h>
#include <hip/hip_cooperative_groups.h>
#include <cstdio>
namespace cg = cooperative_groups;

#define DI __device__ __forceinline__
typedef unsigned short bf16_t;
typedef short bf16x8 __attribute__((ext_vector_type(8)));
typedef float f32x4 __attribute__((ext_vector_type(4)));
typedef float f32x2 __attribute__((ext_vector_type(2)));
typedef unsigned u32x4 __attribute__((ext_vector_type(4)));
typedef unsigned u32x2 __attribute__((ext_vector_type(2)));
typedef __bf16 bf16v2 __attribute__((ext_vector_type(2)));

constexpr int T_SEQ = 8192, MTOK = 16384;
constexpr size_t MiB = (size_t)1 << 20;
constexpr int LDS_BYTES = 147456;
constexpr float EPS = 1e-6f;
#ifndef PHREP
#define PHREP 0u
#endif

constexpr size_t DO_GATE = 0, DO_WTIN = 32 * MiB, DO_WTOUT0 = 41 * MiB, DO_BA = 44 * MiB, DO_GL = 45 * MiB;
constexpr size_t WS_PROJ = 0, WS_H0 = 96 * MiB, WS_FRAGS = 96 * MiB, WS_O32 = 0, WS_ON = 64 * MiB;
constexpr size_t WS_WUP0 = 192 * MiB, WS_WDN0 = 200 * MiB, WS_WQKV = 208 * MiB, WS_WO1 = 214 * MiB, WS_WUP1 = 216 * MiB, WS_WDN1 = 224 * MiB;
constexpr size_t WS_BAR = 240 * MiB;
constexpr size_t WS_MIX_A = 96 * MiB;
constexpr size_t WS_UP = 64 * MiB;
constexpr size_t WS_QK = 64 * MiB, WS_VT = 128 * MiB;
constexpr int FRAG_CHUNK = 73728;

struct Params {
    const float* in[17];
    float* out;
    unsigned char* ws;
};

DI unsigned pk2(float a, float b) { f32x2 v = {a, b}; return __builtin_bit_cast(unsigned, __builtin_convertvector(v, bf16v2)); }
DI float bflo(unsigned u) { return __uint_as_float(u << 16); }
DI float bfhi(unsigned u) { return __uint_as_float(u & 0xffff0000u); }
DI f32x4 mfma16(bf16x8 a, bf16x8 b, f32x4 c) { return __builtin_amdgcn_mfma_f32_16x16x32_bf16(a, b, c, 0, 0, 0); }
DI bf16x8 mk8(u32x2 lo, u32x2 hi) { u32x4 v = {lo.x, lo.y, hi.x, hi.y}; return __builtin_bit_cast(bf16x8, v); }
DI bf16x8 pack8(f32x4 a, f32x4 b) { u32x4 v = {pk2(a[0], a[1]), pk2(a[2], a[3]), pk2(b[0], b[1]), pk2(b[2], b[3])}; return __builtin_bit_cast(bf16x8, v); }
DI float wave_sum(float v) {
#pragma unroll
    for (int o = 1; o < 64; o <<= 1) v += __shfl_xor(v, o);
    return v;
}
#define LDS_WAIT() asm volatile("s_waitcnt lgkmcnt(0)" ::: "memory")

#define XB_TMO      128
#define XB_XCNT(j)  (256  + 64 * (j))
#define XB_XSUB(j)  (1280 + 64 * (j))
#define XB_XGEN(j)  (2304 + 64 * (j))
#define XB_TOP      3328
#define XB_TOPGEN   3392
#define XCD_BAR_WORDS 3456
#define XB_SPIN_CAP (1u << 18)
#define LAS __attribute__((address_space(3)))
DI unsigned xb_ld(unsigned* p)              { return __hip_atomic_load(p, __ATOMIC_RELAXED, __HIP_MEMORY_SCOPE_AGENT); }
DI unsigned xb_add(unsigned* p, unsigned v) { return __hip_atomic_fetch_add(p, v, __ATOMIC_RELAXED, __HIP_MEMORY_SCOPE_AGENT); }
DI unsigned xb_xcc_id() { return (unsigned)__builtin_amdgcn_s_getreg((3 << 11) | 20) & 0xFu; }
#define XB_SPIN(cond, bar) do { unsigned _sp = 0; while (cond) { __builtin_amdgcn_s_sleep(1); \
    if ((++_sp & 255u) == 0u) { if (xb_ld(&(bar)[XB_TMO])) break; if (_sp > XB_SPIN_CAP) { atomicAdd(&(bar)[XB_TMO], 1u); break; } } } } while (0)
struct XcdBarrier { unsigned* bar; unsigned x; volatile LAS unsigned* st; };
DI XcdBarrier xcd_barrier_post(unsigned* bar, volatile LAS unsigned* st) {
    XcdBarrier b; b.bar = bar; b.x = xb_xcc_id(); b.st = st;
    if (threadIdx.x == 0) (void)xb_add(&bar[XB_XCNT(b.x)], 1u);
    return b;
}
DI void xcd_barrier_complete(unsigned* bar, unsigned x, unsigned& nloc, unsigned& nx) {
    const unsigned G = gridDim.x * gridDim.y * gridDim.z;
    unsigned sum, cnt, mine, sp = 0u;
    for (;;) {
        sum = 0u; cnt = 0u; mine = 0u;
#pragma unroll
        for (unsigned j = 0; j < 16; ++j) { const unsigned c = xb_ld(&bar[XB_XCNT(j)]); sum += c; cnt += (c > 0u) ? 1u : 0u; mine = (j == x) ? c : mine; }
        if (sum == G) break;
        __builtin_amdgcn_s_sleep(1);
        if ((++sp & 255u) == 0u) { if (xb_ld(&bar[XB_TMO])) break; if (sp > XB_SPIN_CAP) { atomicAdd(&bar[XB_TMO], 1u); break; } }
    }
    nloc = mine > 0u ? mine : 1u; nx = cnt > 0u ? cnt : 1u;
}
DI void xcd_barrier(const XcdBarrier& b) {
    asm volatile("s_waitcnt vmcnt(0)" ::: "memory");
    __syncthreads();
    if (threadIdx.x == 0) {
        unsigned* bar = b.bar;
        __builtin_amdgcn_s_waitcnt(0);
        unsigned nloc = b.st[0], nx = b.st[1];
        if (nloc == 0u) { xcd_barrier_complete(bar, b.x, nloc, nx); b.st[0] = nloc; b.st[1] = nx; }
        const unsigned old = xb_add(&bar[XB_XSUB(b.x)], 1u);
        const unsigned gen = old / nloc;
        if (old + 1u == (gen + 1u) * nloc) {
            __builtin_amdgcn_fence(__ATOMIC_RELEASE, "agent");
            asm volatile("s_waitcnt vmcnt(0)" ::: "memory");
            const unsigned og = xb_add(&bar[XB_TOP], 1u);
            const unsigned tg = og / nx;
            if (og + 1u == (tg + 1u) * nx) xb_add(&bar[XB_TOPGEN], 1u);
            else XB_SPIN(xb_ld(&bar[XB_TOPGEN]) == tg, bar);
            __builtin_amdgcn_fence(__ATOMIC_ACQUIRE, "agent");
            xb_add(&bar[XB_XGEN(b.x)], 1u);
            asm volatile("s_waitcnt vmcnt(0)" ::: "memory");
        } else {
            XB_SPIN(xb_ld(&bar[XB_XGEN(b.x)]) == gen, bar);
            __builtin_amdgcn_fence(__ATOMIC_ACQUIRE, "agent");
            asm volatile("s_waitcnt vmcnt(0)" ::: "memory");
        }
    }
    __syncthreads();
}

DI void transpose_item(const float* __restrict__ W, int ldw, int col_off, int N, int K, const float* __restrict__ gain, bf16_t* __restrict__ WT, float* scr, int item, int lane) {
    const int nblk = (N + 31) >> 5, kb = item / nblk, nb = item - kb * nblk, k0 = kb * 64, n0 = nb * 32;
    const int nn = n0 + (lane & 31);
    const bool ok = nn < N;
#pragma unroll 8
    for (int i = 0; i < 32; ++i) {
        const int kk = 2 * i + (lane >> 5);
        float v = ok ? W[(size_t)(k0 + kk) * ldw + col_off + nn] : 0.f;
        if (gain) v *= gain[k0 + kk];
        scr[kk * 33 + (lane & 31)] = v;
    }
    LDS_WAIT();
    const int c = lane & 7;
#pragma unroll
    for (int j = 0; j < 4; ++j) {
        const int n = (lane >> 3) + 8 * j;
        const float* s = scr + (8 * c) * 33 + n;
        u32x4 o = {pk2(s[0], s[33]), pk2(s[66], s[99]), pk2(s[132], s[165]), pk2(s[198], s[231])};
        if (n0 + n < N) *(u32x4*)(WT + (size_t)(n0 + n) * K + k0 + 8 * c) = o;
    }
    LDS_WAIT();
}

template <int MODE>
DI void row_pass(const float* __restrict__ xin, const bf16_t* __restrict__ mix, const float* __restrict__ gain, float* __restrict__ xout, bf16_t* __restrict__ H, int gw, int ngw, int lane) {
    for (int row0 = gw; row0 < MTOK; row0 += 2 * ngw) {
        f32x4 v[2][4]; u32x2 mr[2][4];
#pragma unroll
        for (int u = 0; u < 2; ++u) {
            const size_t ro = (size_t)(row0 + u * ngw) * 1024 + 4 * lane;
#pragma unroll
            for (int j = 0; j < 4; ++j) v[u][j] = *(const f32x4*)(xin + ro + 256 * j);
            if (MODE >= 1) {
#pragma unroll
                for (int j = 0; j < 4; ++j) mr[u][j] = *(const u32x2*)(mix + ro + 256 * j);
            }
        }
#pragma unroll
        for (int u = 0; u < 2; ++u) {
            const size_t ro = (size_t)(row0 + u * ngw) * 1024 + 4 * lane;
            if (MODE >= 1) {
                f32x4 m[4]; float ss = 0.f;
#pragma unroll
                for (int j = 0; j < 4; ++j) {
                    m[j] = (f32x4){bflo(mr[u][j].x), bfhi(mr[u][j].x), bflo(mr[u][j].y), bfhi(mr[u][j].y)};
                    ss += (m[j][0] * m[j][0] + m[j][1] * m[j][1]) + (m[j][2] * m[j][2] + m[j][3] * m[j][3]);
                }
                const float rs = rsqrtf(wave_sum(ss) * (1.f / 1024.f) + EPS);
#pragma unroll
                for (int j = 0; j < 4; ++j) {
                    const f32x4 g = *(const f32x4*)(gain + 256 * j + 4 * lane);
                    v[u][j] = v[u][j] + m[j] * rs * g;
                    *(f32x4*)(xout + ro + 256 * j) = v[u][j];
                }
            }
            if (MODE != 2) {
                float ss = 0.f;
#pragma unroll
                for (int j = 0; j < 4; ++j) ss += (v[u][j][0] * v[u][j][0] + v[u][j][1] * v[u][j][1]) + (v[u][j][2] * v[u][j][2] + v[u][j][3] * v[u][j][3]);
                const float rs = rsqrtf(wave_sum(ss) * (1.f / 1024.f) + EPS);
#pragma unroll
                for (int j = 0; j < 4; ++j) {
                    u32x2 o = {pk2(v[u][j][0] * rs, v[u][j][1] * rs), pk2(v[u][j][2] * rs, v[u][j][3] * rs)};
                    *(u32x2*)(H + ro + 256 * j) = o;
                }
            }
        }
    }
}

namespace pg8 {
#define PG8_LAS __attribute__((address_space(3)))
typedef unsigned short bf16_t;
typedef short bf16x8 __attribute__((ext_vector_type(8)));
typedef float f32x4 __attribute__((ext_vector_type(4)));
typedef unsigned u32x4 __attribute__((ext_vector_type(4)));
constexpr int BM = 256, BK = 64, HALF = 128, HTB = HALF * BK * 2  , STAGE_BYTES = 8 * HTB, NXCD = 8, WGM = 8;

__host__ __device__ __forceinline__ int lds_byte(int r, int c) { const int st = (r >> 4) * 2 + (c >> 5), rr = r & 15, cc = c & 31, ob = rr * 64 + cc * 2; return st * 1024 + (ob ^ (((ob >> 9) & 1) << 5)); }
__host__ __device__ __forceinline__ void stage_rc(int b, int& R, int& C) { const int st = b / 1024, sb = b % 1024, swz = sb ^ (((sb >> 9) & 1) << 5); R = (st >> 1) * 16 + swz / 64; C = (st & 1) * 32 + (swz % 64) / 2; }
__host__ __device__ __forceinline__ int perm32(int rho) { const int n = rho >> 4, i = rho & 15; return 8 * (i >> 2) + 4 * n + (i & 3); }

struct Unit { int pm, pn; };
struct Gemm { const bf16_t* A; const bf16_t* Bt; int M, N, K; };

struct StaticOrder {
    int nM, nN, nwg, G, c;
    __host__ __device__ void init(int M, int N, int G_, int c_) { nM = M / BM; nN = N / BM; nwg = nM * nN; G = G_; c = c_; }
    __host__ __device__ bool next(int i, Unit& u) const {
        const long L = (long)i * G + c; if (L >= nwg) return false;
        int wgid = (int)L; { const int q = nwg / NXCD, r = nwg % NXCD, xcd = wgid % NXCD, off = wgid / NXCD; wgid = (xcd < r ? xcd * (q + 1) : r * (q + 1) + (xcd - r) * q) + off; }
        const int nig = WGM * nN, gid = wgid / nig, fm = gid * WGM, gsz = (nM - fm) < WGM ? (nM - fm) : WGM;
        u.pm = fm + ((wgid % nig) % gsz); u.pn = (wgid % nig) / gsz; return true;
    }
    __device__ __forceinline__ void a_ready(const Unit&) const {}
    __device__ __forceinline__ void done(const Unit&) const {}
};

template <class Epi, class Sched, bool ALIGN_EPI = false, bool SP2 = false>
__device__ __forceinline__ void gemm_phase(PG8_LAS unsigned char* lds, const Gemm g, const Sched& S, const Epi& E) {
    const int tid = threadIdx.x, wid = __builtin_amdgcn_readfirstlane(tid >> 6), lane = tid & 63, wr = wid >> 2, wc = wid & 3, fr = lane & 15, fq = lane >> 4;
    const int K = g.K, nt = K / BK;
    unsigned voffA[2], voffB[2];
#pragma unroll
    for (int i = 0; i < 2; ++i) { int R, C; stage_rc(tid * 16 + i * 8192, R, C); const int Rb = Epi::PERM ? ((R & ~31) + perm32(R & 31)) : R;
        voffA[i] = (unsigned)(R * K + C) * 2u; voffB[i] = (unsigned)(Rb * K + C) * 2u; }
    const size_t kstep = (size_t)(BK * 2);
    const size_t hstep = (size_t)HALF * K * 2;
    const size_t tstep = 2 * hstep;
    const unsigned ldsw = (unsigned)wid * 1024u;
    const int aoff = lds_byte(wr * 64 + fr, fq * 8), boff = lds_byte(wc * 32 + fr, fq * 8);
#define PG8_SA(b, h) (((b) * 2 + (h)) * HTB)
#define PG8_SB(b, h) ((4 + (b) * 2 + (h)) * HTB)
#define PG8_STAGE(bufoff, gbase, voff) do { _Pragma("unroll") for (int _i = 0; _i < 2; ++_i) \
        __builtin_amdgcn_global_load_lds((const unsigned*)((const char*)(gbase) + (voff)[_i]), (PG8_LAS unsigned*)(lds + (bufoff) + ldsw + _i * 8192), 16, 0, 0); } while (0)
#define PG8_LDA(dst, b, h) do { _Pragma("unroll") for (int m = 0; m < 4; ++m) _Pragma("unroll") for (int k = 0; k < 2; ++k) dst[m][k] = *(const PG8_LAS bf16x8*)(lds + PG8_SA(b, h) + aoff + m * 2048 + k * 1024); } while (0)
#define PG8_LDB(dst, b, h) do { _Pragma("unroll") for (int n = 0; n < 2; ++n) _Pragma("unroll") for (int k = 0; k < 2; ++k) dst[n][k] = *(const PG8_LAS bf16x8*)(lds + PG8_SB(b, h) + boff + n * 2048 + k * 1024); } while (0)
#define PG8_MMA(ai, bj, At, Bt) do { __builtin_amdgcn_s_setprio(1); _Pragma("unroll") for (int m = 0; m < 4; ++m) _Pragma("unroll") for (int n = 0; n < 2; ++n) _Pragma("unroll") for (int k = 0; k < 2; ++k) \
        acc[ai][bj][m][n] = __builtin_amdgcn_mfma_f32_16x16x32_bf16(Bt[n][k], At[m][k], acc[ai][bj][m][n], 0, 0, 0); __builtin_amdgcn_s_setprio(0); } while (0)
#define PG8_WAIT_V(n) asm volatile("s_waitcnt vmcnt(" #n ")" ::: "memory")
#define PG8_WAIT_L(n) asm volatile("s_waitcnt lgkmcnt(" #n ")" ::: "memory")
#define PG8_BAR __builtin_amdgcn_s_barrier()
#define PG8_SCHED __builtin_amdgcn_sched_barrier(0)
    Unit cur, nxt; int ui = 0;
    if (!S.next(0, cur)) return;
    f32x4 acc[2][2][4][2];
#pragma unroll
    for (int a = 0; a < 2; ++a)
#pragma unroll
        for (int b = 0; b < 2; ++b)
#pragma unroll
            for (int m = 0; m < 4; ++m)
#pragma unroll
                for (int n = 0; n < 2; ++n) acc[a][b][m][n] = (f32x4){0.f, 0.f, 0.f, 0.f};
    bf16x8 At[4][2], B0[2][2], B1[2][2];
    const char* cA = (const char*)g.A + (size_t)cur.pm * tstep; const char* cB = (const char*)g.Bt + (size_t)cur.pn * tstep;
    S.a_ready(cur);
    if constexpr (SP2) {
        PG8_STAGE(PG8_SB(0, 0), cB, voffB); PG8_STAGE(PG8_SB(0, 1), cB + hstep, voffB); PG8_STAGE(PG8_SA(0, 0), cA, voffA); PG8_STAGE(PG8_SA(0, 1), cA + hstep, voffA);
        if (wr == 1) PG8_BAR;
        PG8_WAIT_V(2); PG8_BAR;
        PG8_STAGE(PG8_SB(1, 0), cB + kstep, voffB); PG8_STAGE(PG8_SA(1, 0), cA + kstep, voffA); PG8_STAGE(PG8_SB(1, 1), cB + hstep + kstep, voffB);
        PG8_WAIT_V(6); PG8_BAR;
    } else {
        PG8_STAGE(PG8_SB(0, 0), cB, voffB); PG8_STAGE(PG8_SA(0, 0), cA, voffA); PG8_STAGE(PG8_SB(0, 1), cB + hstep, voffB); PG8_STAGE(PG8_SA(0, 1), cA + hstep, voffA);
        if (wr == 1) PG8_BAR;
        PG8_WAIT_V(4); PG8_BAR;
        PG8_STAGE(PG8_SB(1, 0), cB + kstep, voffB); PG8_STAGE(PG8_SA(1, 0), cA + kstep, voffA); PG8_STAGE(PG8_SB(1, 1), cB + hstep + kstep, voffB);
        PG8_WAIT_V(6); PG8_BAR;
    }
    for (;;) {
        const bool has_next = S.next(ui + 1, nxt);
        const char* nA = has_next ? (const char*)g.A + (size_t)nxt.pm * tstep : cA; const char* nB = has_next ? (const char*)g.Bt + (size_t)nxt.pn * tstep : cB;
        for (int t = 0; t < nt; t += 2) {
            const bool last = (t == nt - 2);
            const char* a1 = cA + (size_t)(t + 1) * kstep;
            const char* a2 = last ? nA : cA + (size_t)(t + 2) * kstep; const char* b2 = last ? nB : cB + (size_t)(t + 2) * kstep;
            const char* a3 = a2 + kstep; const char* b3 = b2 + kstep;
            if (last && has_next) S.a_ready(nxt);
            if constexpr (SP2) {
            PG8_LDB(B0, 0, 0); PG8_LDB(B1, 0, 1); PG8_SCHED; PG8_LDA(At, 0, 0); PG8_STAGE(PG8_SA(1, 1), a1 + hstep, voffA);
            PG8_WAIT_V(8); PG8_WAIT_L(0); PG8_BAR; PG8_MMA(0, 0, At, B0); PG8_MMA(0, 1, At, B1); PG8_BAR; PG8_SCHED;
            PG8_LDA(At, 0, 1); PG8_STAGE(PG8_SB(0, 0), b2, voffB); PG8_STAGE(PG8_SB(0, 1), b2 + hstep, voffB); PG8_STAGE(PG8_SA(0, 0), a2, voffA);
            PG8_WAIT_V(8); PG8_WAIT_L(0); PG8_BAR; PG8_MMA(1, 0, At, B0); PG8_MMA(1, 1, At, B1); PG8_BAR; PG8_SCHED;
            PG8_LDB(B0, 1, 0); PG8_LDB(B1, 1, 1); PG8_SCHED; PG8_LDA(At, 1, 0); PG8_STAGE(PG8_SA(0, 1), a2 + hstep, voffA);
            PG8_WAIT_V(8); PG8_WAIT_L(0); PG8_BAR; PG8_MMA(0, 0, At, B0); PG8_MMA(0, 1, At, B1); PG8_BAR; PG8_SCHED;
            PG8_LDA(At, 1, 1); PG8_STAGE(PG8_SB(1, 0), b3, voffB); PG8_STAGE(PG8_SB(1, 1), b3 + hstep, voffB); PG8_STAGE(PG8_SA(1, 0), a3, voffA);
            PG8_WAIT_V(8); PG8_WAIT_L(0); PG8_BAR; PG8_MMA(1, 0, At, B0); PG8_MMA(1, 1, At, B1); PG8_BAR; PG8_SCHED;
            } else {
            PG8_LDB(B0, 0, 0); PG8_SCHED; PG8_LDA(At, 0, 0); PG8_STAGE(PG8_SA(1, 1), a1 + hstep, voffA);
            PG8_WAIT_L(8); PG8_BAR; PG8_WAIT_L(0); PG8_MMA(0, 0, At, B0); PG8_BAR; PG8_SCHED;
            PG8_LDB(B1, 0, 1); PG8_STAGE(PG8_SB(0, 0), b2, voffB);
            PG8_BAR; PG8_WAIT_L(0); PG8_MMA(0, 1, At, B1); PG8_BAR;
            PG8_LDA(At, 0, 1); PG8_STAGE(PG8_SA(0, 0), a2, voffA);
            PG8_BAR; PG8_WAIT_L(0); PG8_MMA(1, 0, At, B0); PG8_BAR; PG8_SCHED;
            PG8_STAGE(PG8_SB(0, 1), b2 + hstep, voffB);
            PG8_WAIT_V(6); PG8_BAR; PG8_MMA(1, 1, At, B1); PG8_BAR;
            PG8_LDB(B0, 1, 0); PG8_SCHED; PG8_LDA(At, 1, 0); PG8_STAGE(PG8_SA(0, 1), a2 + hstep, voffA);
            PG8_WAIT_L(8); PG8_BAR; PG8_WAIT_L(0); PG8_MMA(0, 0, At, B0); PG8_BAR; PG8_SCHED;
            PG8_LDB(B1, 1, 1); PG8_STAGE(PG8_SB(1, 0), b3, voffB);
            PG8_BAR; PG8_WAIT_L(0); PG8_MMA(0, 1, At, B1); PG8_BAR;
            PG8_LDA(At, 1, 1); PG8_STAGE(PG8_SA(1, 0), a3, voffA);
            PG8_BAR; PG8_WAIT_L(0); PG8_MMA(1, 0, At, B0); PG8_BAR; PG8_SCHED;
            PG8_STAGE(PG8_SB(1, 1), b3 + hstep, voffB);
            PG8_WAIT_V(6); PG8_BAR; PG8_MMA(1, 1, At, B1); PG8_BAR;
            }
        }
        if constexpr (ALIGN_EPI) { if (wr == 0) PG8_BAR; }
        if constexpr (!Epi::AFTER_DRAIN) { E(acc, cur, wr, wc, fr, fq); S.done(cur); }
        if (!has_next) break;
#pragma unroll
        for (int a = 0; a < 2; ++a)
#pragma unroll
            for (int b = 0; b < 2; ++b)
#pragma unroll
                for (int m = 0; m < 4; ++m)
#pragma unroll
                    for (int n = 0; n < 2; ++n) acc[a][b][m][n] = (f32x4){0.f, 0.f, 0.f, 0.f};
        cur = nxt; cA = nA; cB = nB; ++ui;
        if constexpr (ALIGN_EPI) { if (wr == 1) PG8_BAR; }
    }
    PG8_WAIT_V(0);
    if constexpr (!ALIGN_EPI) { if (wr == 0) PG8_BAR; }
    PG8_BAR;
    if constexpr (Epi::AFTER_DRAIN) { E.fused(acc, cur, wr, wc, fr, fq, lds, wid, lane); S.done(cur); }
#undef PG8_SA
#undef PG8_SB
#undef PG8_STAGE
#undef PG8_LDA
#undef PG8_LDB
#undef PG8_MMA
#undef PG8_WAIT_V
#undef PG8_WAIT_L
#undef PG8_BAR
#undef PG8_SCHED
}
}

template <int ACT  > struct EpiStore {
    static constexpr bool PERM = true, AFTER_DRAIN = false;
    bf16_t* O; int ldc; int split_col; bf16_t* O2; int ldc2;
    DI void operator()(const f32x4 (&acc)[2][2][4][2], const pg8::Unit& u, int wr, int wc, int fr, int fq) const {
        const int row0 = u.pm * 256 + wr * 64 + fr; int colt = u.pn * 256; bf16_t* base = O; int ld = ldc;
        if (colt >= split_col) { base = O2; colt -= split_col; ld = ldc2; }
        const int col0 = colt + wc * 32 + 8 * fq;
#pragma unroll
        for (int ai = 0; ai < 2; ++ai)
#pragma unroll
            for (int m = 0; m < 4; ++m) {
                bf16_t* rowp = base + (size_t)(row0 + ai * 128 + m * 16) * ld + col0;
#pragma unroll
                for (int bj = 0; bj < 2; ++bj) {
                    f32x4 v0 = acc[ai][bj][m][0], v1 = acc[ai][bj][m][1];
                    if (ACT == 1) {
#pragma unroll
                        for (int i = 0; i < 4; ++i) { const float a = fmaxf(v0[i], 0.f), b = fmaxf(v1[i], 0.f); v0[i] = a * a; v1[i] = b * b; }
                    }
                    u32x4 w = {pk2(v0[0], v0[1]), pk2(v0[2], v0[3]), pk2(v1[0], v1[1]), pk2(v1[2], v1[3])};
                    *(u32x4*)(rowp + bj * 128) = w;
                }
            }
    }
};
template <int ACT>
DI void run_gemm(unsigned char* lds, const bf16_t* A, const bf16_t* Bt, int M, int N, int K, bf16_t* O, int ldc, int split_col, bf16_t* O2, int ldc2) {
    pg8::Gemm g{A, Bt, M, N, K};
    pg8::StaticOrder S; S.init(M, N, (int)gridDim.x, (int)blockIdx.x);
    EpiStore<ACT> E{O, ldc, split_col, O2, ldc2};
    pg8::gemm_phase<EpiStore<ACT>, pg8::StaticOrder, true, true>((PG8_LAS unsigned char*)lds, g, S, E);
}

DI void skinny16(const bf16_t* __restrict__ A, const bf16_t* __restrict__ Bt16, float* __restrict__ BA, int wu, int lane) {
    const int fr = lane & 15, fq = lane >> 4, r0 = wu * 32;
    f32x4 a0 = {0.f, 0.f, 0.f, 0.f}, a1 = {0.f, 0.f, 0.f, 0.f};
    const bf16_t* ap0 = A + (size_t)(r0 + fr) * 1024 + fq * 8;
    const bf16_t* ap1 = ap0 + 16 * 1024;
    const bf16_t* bp = Bt16 + (size_t)fr * 1024 + fq * 8;
#pragma unroll 4
    for (int ks = 0; ks < 32; ++ks) {
        const bf16x8 b = *(const bf16x8*)(bp + ks * 32);
        a0 = mfma16(b, *(const bf16x8*)(ap0 + ks * 32), a0);
        a1 = mfma16(b, *(const bf16x8*)(ap1 + ks * 32), a1);
    }
    *(f32x4*)(BA + (size_t)(r0 + fr) * 16 + 4 * fq) = a0;
    *(f32x4*)(BA + (size_t)(r0 + 16 + fr) * 16 + 4 * fq) = a1;
}

DI void load_raw(const bf16_t* __restrict__ proj, int cid, u32x4 (&raw)[24]) {
    int tid = threadIdx.x; asm volatile("" : "+v"(tid));
    const int bh = cid >> 7, n = cid & 127, b = bh >> 3, h = bh & 7;
    const int row = tid >> 3, cg8 = tid & 7, t = n * 64 + row;
#pragma unroll
    for (int ph = 0; ph < 6; ++ph) {
        const int cc = (ph >> 1) * 1024 + h * 128 + cg8 * 16 + (ph & 1) * 8;
#pragma unroll
        for (int dt = 0; dt < 4; ++dt) {
            const int tt = t - 3 + dt;
            u32x4 r = {0u, 0u, 0u, 0u};
            if (tt >= 0) r = *(const u32x4*)(proj + (size_t)(b * T_SEQ + tt) * 3072 + cc);
            raw[ph * 4 + dt] = r;
        }
    }
}
DI void conv8(const u32x4* raw4, const float* __restrict__ convw, int cc, float* dst) {
    float acc[8];
#pragma unroll
    for (int i = 0; i < 8; ++i) acc[i] = 0.f;
#pragma unroll
    for (int dt = 0; dt < 4; ++dt) {
        const u32x4 raw = raw4[dt];
        const f32x4 w0 = *(const f32x4*)(convw + dt * 3072 + cc), w1 = *(const f32x4*)(convw + dt * 3072 + cc + 4);
        acc[0] += bflo(raw.x) * w0[0]; acc[1] += bfhi(raw.x) * w0[1]; acc[2] += bflo(raw.y) * w0[2]; acc[3] += bfhi(raw.y) * w0[3];
        acc[4] += bflo(raw.z) * w1[0]; acc[5] += bfhi(raw.z) * w1[1]; acc[6] += bflo(raw.w) * w1[2]; acc[7] += bfhi(raw.w) * w1[3];
    }
#pragma unroll
    for (int i = 0; i < 8; ++i) { float r = acc[i] / (1.f + __expf(-acc[i])); asm volatile("" : "+v"(r)); dst[i] = r; }
}

constexpr int P2_SQ = 0, P2_SK = 17408, P2_SQG = 34816, P2_SKGT = 52224, P2_SKGBT = 70656, P2_SVBT = 89088, P2_SL = 107520, P2_STB = 124928, P2_SG = 134144, P2_SGC = 134400, P2_SBETA = 134656;

DI void gdn_prep_chunk(unsigned char* lds, const bf16_t* __restrict__ proj, const float* __restrict__ BA, const float* __restrict__ convw,
                       const float* __restrict__ a_log, const float* __restrict__ dt_bias, unsigned char* __restrict__ frags, float* __restrict__ GL, int cid, u32x4 (&raw)[24], int next_cid) {
    int tid_ = threadIdx.x; asm volatile("" : "+v"(tid_));
    const int tid = tid_, lane = tid & 63, wid = __builtin_amdgcn_readfirstlane(tid >> 6), fr = lane & 15, fq = lane >> 4;
    const int bh = cid >> 7, n = cid & 127, b = bh >> 3, h = bh & 7;
    float* sg = (float*)(lds + P2_SG); float* sgc = (float*)(lds + P2_SGC); float* sbeta = (float*)(lds + P2_SBETA);
    float* sL = (float*)(lds + P2_SL);
    unsigned char* fbase = frags + (size_t)cid * FRAG_CHUNK;
    const int row = tid >> 3, cg8 = tid & 7, t = n * 64 + row, grow = b * T_SEQ + t;
    float q[16], k[16], v[16];
    {
        const int c0 = h * 128 + cg8 * 16;
        conv8(raw + 0, convw, c0, q); conv8(raw + 4, convw, c0 + 8, q + 8);
        conv8(raw + 8, convw, 1024 + c0, k); conv8(raw + 12, convw, 1024 + c0 + 8, k + 8);
        conv8(raw + 16, convw, 2048 + c0, v); conv8(raw + 20, convw, 2048 + c0 + 8, v + 8);
    }
    float sq = 0.f, sk = 0.f;
#pragma unroll
    for (int i = 0; i < 16; ++i) { sq += q[i] * q[i]; sk += k[i] * k[i]; }
    sq += __shfl_xor(sq, 1); sq += __shfl_xor(sq, 2); sq += __shfl_xor(sq, 4);
    sk += __shfl_xor(sk, 1); sk += __shfl_xor(sk, 2); sk += __shfl_xor(sk, 4);
    const float qs = rsqrtf(sq + EPS) * 0.08838834764831845f, ks_ = rsqrtf(sk + EPS);
    const float braw = BA[(size_t)grow * 16 + h], araw = BA[(size_t)grow * 16 + 8 + h];
    const float beta = 1.f / (1.f + expf(-braw));
    const float xsp = araw + dt_bias[h];
    const float gval = -expf(a_log[h]) * (fmaxf(xsp, 0.f) + log1pf(expf(-fabsf(xsp))));
    if (cg8 == 0) { sg[row] = gval; sbeta[row] = beta; }
    __syncthreads();
    if (wid == 0) {
        float x = sg[lane];
#pragma unroll
        for (int off = 1; off < 64; off <<= 1) { const float y = __shfl_up(x, off); if (lane >= off) x += y; }
        sgc[lane] = x;
    }
    __syncthreads();
    {
        const float gc = sgc[row], glast = sgc[63];
        const float ep = expf(gc), ek = expf(glast - gc);
        u32x4 w0, w1;
#define PK16(dst0, dst1, expr) do { float e_[16]; _Pragma("unroll") for (int i = 0; i < 16; ++i) e_[i] = (expr); \
        dst0 = (u32x4){pk2(e_[0], e_[1]), pk2(e_[2], e_[3]), pk2(e_[4], e_[5]), pk2(e_[6], e_[7])}; dst1 = (u32x4){pk2(e_[8], e_[9]), pk2(e_[10], e_[11]), pk2(e_[12], e_[13]), pk2(e_[14], e_[15])}; } while (0)
        PK16(w0, w1, q[i] * qs);
        *(u32x4*)(lds + P2_SQ + row * 272 + cg8 * 32) = w0; *(u32x4*)(lds + P2_SQ + row * 272 + cg8 * 32 + 16) = w1;
        PK16(w0, w1, k[i] * ks_);
        *(u32x4*)(lds + P2_SK + row * 272 + cg8 * 32) = w0; *(u32x4*)(lds + P2_SK + row * 272 + cg8 * 32 + 16) = w1;
        PK16(w0, w1, q[i] * (qs * ep));
        *(u32x4*)(lds + P2_SQG + row * 272 + cg8 * 32) = w0; *(u32x4*)(lds + P2_SQG + row * 272 + cg8 * 32 + 16) = w1;
        bf16_t* sKGT = (bf16_t*)(lds + P2_SKGT); bf16_t* sKGbT = (bf16_t*)(lds + P2_SKGBT); bf16_t* sVbT = (bf16_t*)(lds + P2_SVBT);
        const float kek = ks_ * ek, kbe = ks_ * beta * ep;
#pragma unroll
        for (int i = 0; i < 16; i += 2) {
            const int d = cg8 * 16 + i;
            const unsigned a = pk2(k[i] * kek, k[i + 1] * kek), bb = pk2(k[i] * kbe, k[i + 1] * kbe), c = pk2(v[i] * beta, v[i + 1] * beta);
            sKGT[d * 72 + row] = (bf16_t)(a & 0xffff); sKGT[(d + 1) * 72 + row] = (bf16_t)(a >> 16);
            sKGbT[d * 72 + row] = (bf16_t)(bb & 0xffff); sKGbT[(d + 1) * 72 + row] = (bf16_t)(bb >> 16);
            sVbT[d * 72 + row] = (bf16_t)(c & 0xffff); sVbT[(d + 1) * 72 + row] = (bf16_t)(c >> 16);
        }
        if (tid == 0) GL[cid] = expf(glast);
    }
    __syncthreads();
    if (next_cid >= 0) load_raw(proj, next_cid, raw);
    {
        const int mi = wid & 3, kc = wid >> 2;
        f32x4 a0 = {0.f, 0.f, 0.f, 0.f}, a1 = {0.f, 0.f, 0.f, 0.f};
#pragma unroll
        for (int ks = 0; ks < 4; ++ks) {
            const bf16x8 qb = *(const bf16x8*)(lds + P2_SQ + (16 * mi + fr) * 272 + ks * 64 + fq * 16);
            const bf16x8 k0 = *(const bf16x8*)(lds + P2_SK + (32 * kc + fr) * 272 + ks * 64 + fq * 16);
            const bf16x8 k1 = *(const bf16x8*)(lds + P2_SK + (32 * kc + 16 + fr) * 272 + ks * 64 + fq * 16);
            a0 = mfma16(k0, qb, a0); a1 = mfma16(k1, qb, a1);
        }
        const int c = 16 * mi + fr; const float gcc = sgc[c];
        f32x4 v0, v1;
#pragma unroll
        for (int r = 0; r < 4; ++r) {
            const int c0 = 32 * kc + 4 * fq + r, c1 = c0 + 16;
            v0[r] = (c >= c0) ? a0[r] * expf(gcc - sgc[c0]) : 0.f;
            v1[r] = (c >= c1) ? a1[r] * expf(gcc - sgc[c1]) : 0.f;
        }
        *(bf16x8*)(fbase + 49152 + ((mi * 2 + kc) * 64 + lane) * 16) = pack8(v0, v1);
        const int it = wid & 3;
#pragma unroll
        for (int jj = 0; jj < 2; ++jj) {
            const int jt = (wid >> 2) * 2 + jj;
            f32x4 acc = {0.f, 0.f, 0.f, 0.f};
#pragma unroll
            for (int ks = 0; ks < 4; ++ks) {
                const bf16x8 ka = *(const bf16x8*)(lds + P2_SK + (16 * it + fr) * 272 + ks * 64 + fq * 16);
                const bf16x8 kb = *(const bf16x8*)(lds + P2_SK + (16 * jt + fr) * 272 + ks * 64 + fq * 16);
                acc = mfma16(ka, kb, acc);
            }
            const int j = 16 * jt + fr; const float gcj = sgc[j];
#pragma unroll
            for (int r = 0; r < 4; ++r) {
                const int i = 16 * it + 4 * fq + r;
                sL[i * 68 + j] = (i > j) ? sbeta[i] * acc[r] * expf(sgc[i] - gcj) : 0.f;
            }
        }
    }
    __syncthreads();
    if (wid == 0) {
        bf16_t* sTb = (bf16_t*)(lds + P2_STB);
        int vz = 0; asm volatile("" : "+v"(vz));
        const float* sLv = sL + vz;
        float x[64];
#pragma unroll
        for (int i = 0; i < 64; ++i) x[i] = 0.f;
#pragma unroll
        for (int i = 0; i < 64; ++i) {
            float a0 = -sL[i * 68 + lane], a1 = 0.f;
#pragma unroll
            for (int mb = 0; mb * 4 < i; ++mb) {
                const f32x4 Lv = *(const f32x4*)(sLv + i * 68 + mb * 4);
                if (mb & 1) { a1 -= Lv[0] * x[4 * mb]; a1 -= Lv[1] * x[4 * mb + 1]; a1 -= Lv[2] * x[4 * mb + 2]; a1 -= Lv[3] * x[4 * mb + 3]; }
                else        { a0 -= Lv[0] * x[4 * mb]; a0 -= Lv[1] * x[4 * mb + 1]; a0 -= Lv[2] * x[4 * mb + 2]; a0 -= Lv[3] * x[4 * mb + 3]; }
            }
            x[i] = a0 + a1;
            sTb[i * 72 + lane] = (bf16_t)(pk2(x[i], 0.f) & 0xffff);
        }
        LDS_WAIT();
        sTb[lane * 72 + lane] = (bf16_t)0x3F80;
    } else {
        for (int slot = tid - 64; slot < 2048; slot += 448) {
            const int f = slot >> 6, l = slot & 63, m = l & 15, g = l >> 4;
            const unsigned char* src; unsigned char* dst;
            if (f < 16) { const int mi = f >> 2, kb = f & 3; src = lds + P2_SQG + (16 * mi + m) * 272 + (32 * kb + 4 * g) * 2; dst = fbase + 16384 + slot * 16; }
            else { const int f2 = f - 16, tt = f2 >> 1, kc = f2 & 1; src = lds + P2_SKGT + (16 * tt + m) * 144 + (32 * kc + 4 * g) * 2; dst = fbase + 32768 + (slot - 1024) * 16; }
            const u32x2 lo = *(const u32x2*)src, hi = *(const u32x2*)(src + 32);
            *(u32x4*)dst = (u32x4){lo.x, lo.y, hi.x, hi.y};
        }
    }
    __syncthreads();
    {
        const int mi = wid & 3;
#pragma unroll
        for (int kk = 0; kk < 2; ++kk) {
            const int kb = (wid >> 2) * 2 + kk;
            f32x4 d0 = {0.f, 0.f, 0.f, 0.f}, d1 = {0.f, 0.f, 0.f, 0.f};
#pragma unroll
            for (int ks = 0; ks < 2; ++ks) {
                const bf16x8 tb = *(const bf16x8*)(lds + P2_STB + (16 * mi + fr) * 144 + ks * 64 + fq * 16);
                const bf16x8 g0 = *(const bf16x8*)(lds + P2_SKGBT + (32 * kb + fr) * 144 + ks * 64 + fq * 16);
                const bf16x8 g1 = *(const bf16x8*)(lds + P2_SKGBT + (32 * kb + 16 + fr) * 144 + ks * 64 + fq * 16);
                d0 = mfma16(g0, tb, d0); d1 = mfma16(g1, tb, d1);
            }
            *(bf16x8*)(fbase + ((mi * 4 + kb) * 64 + lane) * 16) = pack8(d0, d1);
        }
#pragma unroll
        for (int q4 = 0; q4 < 4; ++q4) {
            const int dvt = (wid >> 2) * 4 + q4;
            f32x4 u = {0.f, 0.f, 0.f, 0.f};
#pragma unroll
            for (int ks = 0; ks < 2; ++ks) {
                const bf16x8 ta = *(const bf16x8*)(lds + P2_STB + (16 * mi + fr) * 144 + ks * 64 + fq * 16);
                const bf16x8 vb = *(const bf16x8*)(lds + P2_SVBT + (16 * dvt + fr) * 144 + ks * 64 + fq * 16);
                u = mfma16(ta, vb, u);
            }
            u32x2 o = {pk2(u[0], u[1]), pk2(u[2], u[3])};
            *(u32x2*)(fbase + 57344 + dvt * 2048 + mi * 512 + lane * 8) = o;
        }
    }
    __syncthreads();
}

constexpr int P3_STEP = 59392;
constexpr int P3_HAND = 2 * P3_STEP, P3_GL = P3_HAND + 2 * 6144;
DI void gdn_scan(unsigned char* lds, const unsigned char* __restrict__ frags, const float* __restrict__ GL, float* __restrict__ O, int item) {
    const int tid = threadIdx.x, lane = tid & 63, wid = __builtin_amdgcn_readfirstlane(tid >> 6), fr = lane & 15, fq = lane >> 4;
    const int bh = item >> 3, slice = item & 7, b = bh >> 3, h = bh & 7;
    float* sGL = (float*)(lds + P3_GL);
    if (tid < 128) sGL[tid] = GL[bh * 128 + tid];
    const int lt = tid - 128;
    u32x4 rg[10];
    auto issue = [&](int m) {
#pragma unroll
        for (int i = 0; i < 10; ++i) {
            const int qq = lt + 384 * i;
            const bool prev = (qq >= 1024 && qq < 2048) || (qq >= 3072 && qq < 3584);
            const int c = m - (prev ? 1 : 0);
            if (qq < 3712 && c >= 0 && c < 128) {
                const unsigned char* src = frags + (size_t)(bh * 128 + c) * FRAG_CHUNK;
                rg[i] = *(const u32x4*)(qq < 3584 ? src + qq * 16 : src + 57344 + slice * 2048 + (qq - 3584) * 16);
            }
        }
    };
    auto commit = [&](int buf) {
        unsigned char* dst = lds + buf * P3_STEP;
#pragma unroll
        for (int i = 0; i < 10; ++i) { const int qq = lt + 384 * i; if (qq < 3712) *(u32x4*)(dst + qq * 16) = rg[i]; }
    };
    if (wid > 1) { issue(0); commit(0); issue(1); }
    f32x4 S[8];
#pragma unroll
    for (int t = 0; t < 8; ++t) S[t] = (f32x4){0.f, 0.f, 0.f, 0.f};
    __syncthreads();
    for (int m = 0; m <= 128; ++m) {
        const unsigned char* Bf = lds + (m & 1) * P3_STEP;
        if (wid > 1) {
            if (m + 1 <= 128) commit((m + 1) & 1);
            if (m + 2 <= 128) issue(m + 2);
        } else if (wid == 0) {
            if (m < 128) {
                unsigned char* hand = lds + P3_HAND + (m & 1) * 6144;
                const float gl = sGL[m];
                bf16x8 Sb[4];
#pragma unroll
                for (int kb = 0; kb < 4; ++kb) { Sb[kb] = pack8(S[2 * kb], S[2 * kb + 1]); *(bf16x8*)(hand + (kb * 64 + lane) * 16) = Sb[kb]; }
                f32x4 P[4];
#pragma unroll
                for (int mi = 0; mi < 4; ++mi) P[mi] = (f32x4){0.f, 0.f, 0.f, 0.f};
#pragma unroll
                for (int kb = 0; kb < 4; ++kb)
#pragma unroll
                    for (int mi = 0; mi < 4; ++mi) P[mi] = mfma16(*(const bf16x8*)(Bf + ((mi * 4 + kb) * 64 + lane) * 16), Sb[kb], P[mi]);
                f32x4 vn[4];
#pragma unroll
                for (int mi = 0; mi < 4; ++mi) {
                    const u32x2 ur = *(const u32x2*)(Bf + 57344 + mi * 512 + lane * 8);
                    vn[mi] = (f32x4){bflo(ur.x), bfhi(ur.x), bflo(ur.y), bfhi(ur.y)} - P[mi];
                }
                bf16x8 Vb[2];
                Vb[0] = pack8(vn[0], vn[1]); Vb[1] = pack8(vn[2], vn[3]);
                *(bf16x8*)(hand + 4096 + lane * 16) = Vb[0]; *(bf16x8*)(hand + 4096 + (64 + lane) * 16) = Vb[1];
#pragma unroll
                for (int t = 0; t < 8; ++t) S[t] = S[t] * gl;
#pragma unroll
                for (int kc = 0; kc < 2; ++kc)
#pragma unroll
                    for (int t = 0; t < 8; ++t) S[t] = mfma16(*(const bf16x8*)(Bf + 32768 + ((t * 2 + kc) * 64 + lane) * 16), Vb[kc], S[t]);
            }
        } else {
            if (m >= 1) {
                const unsigned char* hand = lds + P3_HAND + ((m - 1) & 1) * 6144;
                bf16x8 Sb[4], Vb[2];
#pragma unroll
                for (int kb = 0; kb < 4; ++kb) Sb[kb] = *(const bf16x8*)(hand + (kb * 64 + lane) * 16);
                Vb[0] = *(const bf16x8*)(hand + 4096 + lane * 16); Vb[1] = *(const bf16x8*)(hand + 4096 + (64 + lane) * 16);
                f32x4 Oa[4];
#pragma unroll
                for (int mi = 0; mi < 4; ++mi) Oa[mi] = (f32x4){0.f, 0.f, 0.f, 0.f};
#pragma unroll
                for (int kb = 0; kb < 4; ++kb)
#pragma unroll
                    for (int mi = 0; mi < 4; ++mi) Oa[mi] = mfma16(*(const bf16x8*)(Bf + 16384 + ((mi * 4 + kb) * 64 + lane) * 16), Sb[kb], Oa[mi]);
#pragma unroll
                for (int kc = 0; kc < 2; ++kc)
#pragma unroll
                    for (int mi = 0; mi < 4; ++mi) Oa[mi] = mfma16(*(const bf16x8*)(Bf + 49152 + ((mi * 2 + kc) * 64 + lane) * 16), Vb[kc], Oa[mi]);
                float* op = O + ((size_t)(b * T_SEQ + (m - 1) * 64 + 4 * fq)) * 1024 + h * 128 + slice * 16 + fr;
#pragma unroll
                for (int mi = 0; mi < 4; ++mi)
#pragma unroll
                    for (int r = 0; r < 4; ++r) op[(size_t)(16 * mi + r) * 1024] = Oa[mi][r];
            }
        }
        __syncthreads();
    }
}

DI void gated_norm(const float* __restrict__ O, const bf16_t* __restrict__ gate, const float* __restrict__ out_gain, bf16_t* __restrict__ ON, int gw, int ngw, int lane) {
    f32x4 gn[4];
#pragma unroll
    for (int j = 0; j < 4; ++j) gn[j] = *(const f32x4*)(out_gain + ((lane & 7) * 16) + 4 * j);
    for (int row = gw; row < MTOK; row += ngw) {
        f32x4 o[4]; float ss = 0.f;
#pragma unroll
        for (int j = 0; j < 4; ++j) { o[j] = *(const f32x4*)(O + (size_t)row * 1024 + lane * 16 + 4 * j); ss += (o[j][0] * o[j][0] + o[j][1] * o[j][1]) + (o[j][2] * o[j][2] + o[j][3] * o[j][3]); }
        ss += __shfl_xor(ss, 1); ss += __shfl_xor(ss, 2); ss += __shfl_xor(ss, 4);
        const float rs = rsqrtf(ss * (1.f / 128.f) + EPS);
        const u32x4 g0 = *(const u32x4*)(gate + (size_t)row * 1024 + lane * 16), g1 = *(const u32x4*)(gate + (size_t)row * 1024 + lane * 16 + 8);
        float gv[16] = {bflo(g0.x), bfhi(g0.x), bflo(g0.y), bfhi(g0.y), bflo(g0.z), bfhi(g0.z), bflo(g0.w), bfhi(g0.w),
                        bflo(g1.x), bfhi(g1.x), bflo(g1.y), bfhi(g1.y), bflo(g1.z), bfhi(g1.z), bflo(g1.w), bfhi(g1.w)};
        float r[16];
#pragma unroll
        for (int i = 0; i < 16; ++i) { const float g = gv[i]; r[i] = o[i >> 2][i & 3] * rs * gn[i >> 2][i & 3] * (g / (1.f + __expf(-g))); }
        u32x4 w0 = {pk2(r[0], r[1]), pk2(r[2], r[3]), pk2(r[4], r[5]), pk2(r[6], r[7])}, w1 = {pk2(r[8], r[9]), pk2(r[10], r[11]), pk2(r[12], r[13]), pk2(r[14], r[15])};
        *(u32x4*)(ON + (size_t)row * 1024 + lane * 16) = w0; *(u32x4*)(ON + (size_t)row * 1024 + lane * 16 + 8) = w1;
    }
}

constexpr int SB_BUF = 35840, SB_SV = 17408;
DI void sb_attn_block(unsigned char* lds, const bf16_t* __restrict__ QK, const bf16_t* __restrict__ VT, bf16_t* __restrict__ ATT, int task) {
    int tid_ = threadIdx.x; asm volatile("" : "+v"(tid_));
    const int tid = tid_, lane = tid & 63, wid = __builtin_amdgcn_readfirstlane(tid >> 6), fr = lane & 15, fq = lane >> 4;
    const int qb = task & 63, bh = task >> 6, b = bh >> 3, h = bh & 7;
    const int t0 = qb * 128, tw = t0 + wid * 16, tq = tw + fr;
    const size_t rowbase = (size_t)b * T_SEQ;
    bf16x8 qf[4];
    {
        const bf16_t* qp = QK + (rowbase + tq) * 2048 + h * 128 + fq * 8;
#pragma unroll
        for (int ks = 0; ks < 4; ++ks) qf[ks] = *(const bf16x8*)(qp + ks * 32);
    }
    f32x4 oacc[8];
#pragma unroll
    for (int d = 0; d < 8; ++d) oacc[d] = (f32x4){0.f, 0.f, 0.f, 0.f};
    float carry = 0.f;
    const float scale = 0.08838834764831845f;
    const bf16_t* ksrc[2]; const bf16_t* vsrc[2]; int kdst[2], vdst[2];
#pragma unroll
    for (int i = 0; i < 2; ++i) {
        const int q = tid + 512 * i;
        const int krow = q >> 4, kc = q & 15; ksrc[i] = QK + (rowbase + krow) * 2048 + 1024 + h * 128 + kc * 8; kdst[i] = krow * 272 + kc * 16;
        const int vrow = q >> 3, vc = q & 7; vsrc[i] = VT + ((size_t)h * 128 + vrow) * MTOK + rowbase + vc * 8; vdst[i] = SB_SV + vrow * 144 + vc * 16;
    }
    u32x4 rk[2], rv[2];
    int kt = (t0 >> 6) + 1;
#pragma unroll
    for (int i = 0; i < 2; ++i) { rk[i] = *(const u32x4*)(ksrc[i] + (size_t)kt * 64 * 2048); rv[i] = *(const u32x4*)(vsrc[i] + kt * 64); }
#pragma unroll
    for (int i = 0; i < 2; ++i) { *(u32x4*)(lds + kdst[i]) = rk[i]; *(u32x4*)(lds + vdst[i]) = rv[i]; }
    __syncthreads();
    for (int it = 0;; ++it, --kt) {
        const bool more = kt > 0;
        if (more) {
#pragma unroll
            for (int i = 0; i < 2; ++i) { rk[i] = *(const u32x4*)(ksrc[i] + (size_t)(kt - 1) * 64 * 2048); rv[i] = *(const u32x4*)(vsrc[i] + (kt - 1) * 64); }
        }
        const int s0 = kt * 64;
        if (s0 < tw + 15) {
            const unsigned char* sK = lds + (it & 1) * SB_BUF;
            const unsigned char* sV = sK + SB_SV;
            f32x4 z[4];
#pragma unroll
            for (int j = 0; j < 4; ++j) {
                z[j] = (f32x4){0.f, 0.f, 0.f, 0.f};
#pragma unroll
                for (int ks = 0; ks < 4; ++ks) z[j] = mfma16(*(const bf16x8*)(sK + (16 * j + fr) * 272 + ks * 64 + fq * 16), qf[ks], z[j]);
            }
            f32x4 lb[4], lm[4]; float TT[4], E[4];
#pragma unroll
            for (int j = 0; j < 4; ++j) {
                float Tj = 0.f;
#pragma unroll
                for (int r = 0; r < 4; ++r) {
                    const int s = s0 + 16 * j + 4 * fq + r;
                    const float zz = z[j][r] * scale;
                    const float sp = fmaxf(-zz, 0.f) + __logf(1.f + __expf(-fabsf(zz)));
                    lb[j][r] = -sp;
                    const float m_ = (s < tq) ? (-sp - zz) : 0.f;
                    lm[j][r] = m_; Tj += m_;
                }
                const float b_ = __shfl_xor(Tj, 16); const float c_ = Tj + b_; const float d_ = __shfl_xor(c_, 32);
                TT[j] = c_ + d_;
                E[j] = ((fq & 1) ? 0.f : b_) + ((fq & 2) ? 0.f : d_);
            }
            f32x4 a[4];
            float later = carry;
#pragma unroll
            for (int j = 3; j >= 0; --j) {
                float suf = 0.f;
#pragma unroll
                for (int r = 3; r >= 0; --r) {
                    const int s = s0 + 16 * j + 4 * fq + r;
                    const float tail = suf + E[j] + later;
                    a[j][r] = (s < tq) ? __expf(lb[j][r] + tail) : 0.f;
                    suf += lm[j][r];
                }
                later += TT[j];
            }
            carry = later;
            bf16x8 ab[2];
            ab[0] = pack8(a[0], a[1]); ab[1] = pack8(a[2], a[3]);
#pragma unroll
            for (int dt = 0; dt < 8; ++dt)
#pragma unroll
                for (int kc = 0; kc < 2; ++kc) {
                    const unsigned char* vp = sV + (16 * dt + fr) * 144 + (32 * kc + 4 * fq) * 2;
                    oacc[dt] = mfma16(mk8(*(const u32x2*)vp, *(const u32x2*)(vp + 32)), ab[kc], oacc[dt]);
                }
        }
        if (more) {
            unsigned char* d = lds + ((it + 1) & 1) * SB_BUF;
#pragma unroll
            for (int i = 0; i < 2; ++i) { *(u32x4*)(d + kdst[i]) = rk[i]; *(u32x4*)(d + vdst[i]) = rv[i]; }
        }
        unsigned* flg = (unsigned*)(lds + 2 * SB_BUF) + (it & 1) * 8;
        const int wdone = __all(carry < -120.f);
        if (lane == 0) flg[wid] = (unsigned)wdone;
        __syncthreads();
        const u32x4 f0 = *(const u32x4*)flg, f1 = *(const u32x4*)(flg + 4);
        const bool alldone = (f0.x & f0.y & f0.z & f0.w & f1.x & f1.y & f1.z & f1.w) != 0u;
        if (!more || alldone) break;
    }
    bf16_t* op = ATT + (rowbase + tq) * 1024 + h * 128 + 4 * fq;
#pragma unroll
    for (int dt = 0; dt < 8; ++dt) { u32x2 o = {pk2(oacc[dt][0], oacc[dt][1]), pk2(oacc[dt][2], oacc[dt][3])}; *(u32x2*)(op + 16 * dt) = o; }
}

__global__ void __launch_bounds__(512) yoco_fwd(Params p) {
    extern __shared__ __attribute__((aligned(16))) unsigned char lds[];
    cg::grid_group grid = cg::this_grid();
    const int tid = threadIdx.x, lane = tid & 63, wid = __builtin_amdgcn_readfirstlane(tid >> 6);
    const int G = gridDim.x;
    const int vcu = ((G & 7) == 0) ? ((blockIdx.x & 7) * (G >> 3) + (blockIdx.x >> 3)) : blockIdx.x;
    const int gw = vcu * 8 + wid, ngw = G * 8;
    unsigned char* ws = p.ws;
    unsigned char* dob = (unsigned char*)p.out;
    const float* x = p.in[0];
    float* scr = (float*)(lds + wid * 8448);
    if (tid < 4) ((unsigned*)(lds + 147440))[tid] = 0u;
    __syncthreads();
    const XcdBarrier xb = xcd_barrier_post((unsigned*)(ws + WS_BAR), (volatile LAS unsigned*)(lds + 147440));

    for (int rep_ = 0; rep_ < 1 + (int)((PHREP >> 0) & 1u); ++rep_)
    {
        bf16_t* WTIN = (bf16_t*)(dob + DO_WTIN); bf16_t* WTOUT0 = (bf16_t*)(dob + DO_WTOUT0);
        const int I_IN = 16 * 129, I_OUT = 16 * 32;
        for (int it = gw; it < I_IN + I_OUT; it += ngw) {
            if (it < I_IN) transpose_item(p.in[7], 4112, 0, 4112, 1024, p.in[1], WTIN, scr, it, lane);
            else transpose_item(p.in[12], 1024, 0, 1024, 1024, nullptr, WTOUT0, scr, it - I_IN, lane);
        }
        row_pass<0>(x, nullptr, nullptr, nullptr, (bf16_t*)(ws + WS_H0), gw, ngw, lane);
    }
    grid.sync();
#ifdef SYNCREP
    for (int i_ = 0; i_ < SYNCREP; ++i_) xcd_barrier(xb);
#endif
    for (int rep_ = 0; rep_ < 1 + (int)((PHREP >> 1) & 1u); ++rep_)
    {
        run_gemm<0>(lds, (const bf16_t*)(ws + WS_H0), (const bf16_t*)(dob + DO_WTIN), MTOK, 4096, 1024, (bf16_t*)(ws + WS_PROJ), 3072, 3072, (bf16_t*)(dob + DO_GATE), 1024);
        if (wid < 2) { const int wu = vcu * 2 + wid; if (wu < 512) skinny16((const bf16_t*)(ws + WS_H0), (const bf16_t*)(dob + DO_WTIN) + (size_t)4096 * 1024, (float*)(dob + DO_BA), wu, lane); }
    }
    xcd_barrier(xb);
    for (int rep_ = 0; rep_ < 1 + (int)((PHREP >> 2) & 1u); ++rep_)
    {
        u32x4 raw[24];
        if (vcu < 2048) load_raw((const bf16_t*)(ws + WS_PROJ), vcu, raw);
        for (int cid = vcu; cid < 2048; cid += G)
            gdn_prep_chunk(lds, (const bf16_t*)(ws + WS_PROJ), (const float*)(dob + DO_BA), p.in[8], p.in[9], p.in[10], ws + WS_FRAGS, (float*)(dob + DO_GL), cid, raw, (cid + G < 2048) ? cid + G : -1);
    }
    xcd_barrier(xb);
    for (int rep_ = 0; rep_ < 1 + (int)((PHREP >> 3) & 1u); ++rep_)
    {
        int first, stride;
        if (G == 256) { const int xx = vcu >> 5, j = vcu & 31; first = (j < 16) ? xx * 16 + j : 128; stride = 128; }
        else { first = blockIdx.x; stride = G; }
        for (int item = first; item < 128; item += stride) { gdn_scan(lds, ws + WS_FRAGS, (const float*)(dob + DO_GL), (float*)(ws + WS_O32), item); __syncthreads(); }
    }
    xcd_barrier(xb);
    for (int rep_ = 0; rep_ < 1 + (int)((PHREP >> 4) & 1u); ++rep_)
    {
        gated_norm((const float*)(ws + WS_O32), (const bf16_t*)(dob + DO_GATE), p.in[11], (bf16_t*)(ws + WS_ON), gw, ngw, lane);
        const int I0 = 2048, I1 = I0 + 2048, I2 = I1 + 512, I3 = I2 + 1024, I4 = I3 + 512, I5 = I4 + 2048, I6 = I5 + 2048;
        for (int it = gw; it < I6; it += ngw) {
            if (it < I0) transpose_item(p.in[5], 4096, 0, 4096, 1024, p.in[3], (bf16_t*)(ws + WS_WUP0), scr, it, lane);
            else if (it < I1) transpose_item(p.in[6], 1024, 0, 1024, 4096, nullptr, (bf16_t*)(ws + WS_WDN0), scr, it - I0, lane);
            else if (it < I2) transpose_item(p.in[15], 1024, 0, 1024, 1024, p.in[1] + 1024, (bf16_t*)(ws + WS_WQKV), scr, it - I1, lane);
            else if (it < I3) transpose_item(p.in[14], 2048, 0, 2048, 1024, p.in[13], (bf16_t*)(ws + WS_WQKV) + (size_t)1024 * 1024, scr, it - I2, lane);
            else if (it < I4) transpose_item(p.in[16], 1024, 0, 1024, 1024, nullptr, (bf16_t*)(ws + WS_WO1), scr, it - I3, lane);
            else if (it < I5) transpose_item(p.in[5] + (size_t)1024 * 4096, 4096, 0, 4096, 1024, p.in[3] + 1024, (bf16_t*)(ws + WS_WUP1), scr, it - I4, lane);
            else transpose_item(p.in[6] + (size_t)4096 * 1024, 1024, 0, 1024, 4096, nullptr, (bf16_t*)(ws + WS_WDN1), scr, it - I5, lane);
        }
    }
    xcd_barrier(xb);
    for (int rep_ = 0; rep_ < 1 + (int)((PHREP >> 5) & 1u); ++rep_)
    run_gemm<0>(lds, (const bf16_t*)(ws + WS_ON), (const bf16_t*)(dob + DO_WTOUT0), MTOK, 1024, 1024, (bf16_t*)(ws + WS_MIX_A), 1024, 1 << 30, nullptr, 0);
    xcd_barrier(xb);
    for (int rep_ = 0; rep_ < 1 + (int)((PHREP >> 6) & 1u); ++rep_)
    row_pass<1>(x, (const bf16_t*)(ws + WS_MIX_A), p.in[2], p.out, (bf16_t*)(ws + 0), gw, ngw, lane);
    xcd_barrier(xb);
    for (int rep_ = 0; rep_ < 1 + (int)((PHREP >> 7) & 1u); ++rep_)
    run_gemm<1>(lds, (const bf16_t*)(ws + 0), (const bf16_t*)(ws + WS_WUP0), MTOK, 4096, 1024, (bf16_t*)(ws + WS_UP), 4096, 1 << 30, nullptr, 0);
    xcd_barrier(xb);
    for (int rep_ = 0; rep_ < 1 + (int)((PHREP >> 8) & 1u); ++rep_)
    run_gemm<0>(lds, (const bf16_t*)(ws + WS_UP), (const bf16_t*)(ws + WS_WDN0), MTOK, 1024, 4096, (bf16_t*)(ws + 0), 1024, 1 << 30, nullptr, 0);
    xcd_barrier(xb);
    for (int rep_ = 0; rep_ < 1 + (int)((PHREP >> 9) & 1u); ++rep_)
    row_pass<1>(p.out, (const bf16_t*)(ws + 0), p.in[4], p.out, (bf16_t*)(ws + 32 * MiB), gw, ngw, lane);
    xcd_barrier(xb);
    for (int rep_ = 0; rep_ < 1 + (int)((PHREP >> 10) & 1u); ++rep_)
    {
        run_gemm<0>(lds, (const bf16_t*)(ws + 32 * MiB), (const bf16_t*)(ws + WS_WQKV), MTOK, 2048, 1024, (bf16_t*)(ws + WS_QK), 2048, 1 << 30, nullptr, 0);
        run_gemm<0>(lds, (const bf16_t*)(ws + WS_WQKV) + (size_t)2048 * 1024, (const bf16_t*)(ws + 32 * MiB), 1024, MTOK, 1024, (bf16_t*)(ws + WS_VT), MTOK, 1 << 30, nullptr, 0);
    }
    xcd_barrier(xb);
    for (int rep_ = 0; rep_ < 1 + (int)((PHREP >> 11) & 1u); ++rep_)
    for (int task = vcu; task < 1024; task += G) sb_attn_block(lds, (const bf16_t*)(ws + WS_QK), (const bf16_t*)(ws + WS_VT), (bf16_t*)(ws + 0), task);
    xcd_barrier(xb);
    for (int rep_ = 0; rep_ < 1 + (int)((PHREP >> 12) & 1u); ++rep_)
    run_gemm<0>(lds, (const bf16_t*)(ws + 0), (const bf16_t*)(ws + WS_WO1), MTOK, 1024, 1024, (bf16_t*)(ws + 32 * MiB), 1024, 1 << 30, nullptr, 0);
    xcd_barrier(xb);
    for (int rep_ = 0; rep_ < 1 + (int)((PHREP >> 13) & 1u); ++rep_)
    row_pass<1>(p.out, (const bf16_t*)(ws + 32 * MiB), p.in[2] + 1024, p.out, (bf16_t*)(ws + 0), gw, ngw, lane);
    xcd_barrier(xb);
    for (int rep_ = 0; rep_ < 1 + (int)((PHREP >> 14) & 1u); ++rep_)
    run_gemm<1>(lds, (const bf16_t*)(ws + 0), (const bf16_t*)(ws + WS_WUP1), MTOK, 4096, 1024, (bf16_t*)(ws + WS_UP), 4096, 1 << 30, nullptr, 0);
    xcd_barrier(xb);
    for (int rep_ = 0; rep_ < 1 + (int)((PHREP >> 15) & 1u); ++rep_)
    run_gemm<0>(lds, (const bf16_t*)(ws + WS_UP), (const bf16_t*)(ws + WS_WDN1), MTOK, 1024, 4096, (bf16_t*)(ws + 0), 1024, 1 << 30, nullptr, 0);
    xcd_barrier(xb);
    for (int rep_ = 0; rep_ < 1 + (int)((PHREP >> 16) & 1u); ++rep_)
    row_pass<2>(p.out, (const bf16_t*)(ws + 0), p.in[4] + 1024, p.out, nullptr, gw, ngw, lane);
}

extern "C" void kernel_launch(void* const* d_in, const int* in_sizes, int n_in, void* d_out, int out_size, void* d_ws, size_t ws_size, hipStream_t stream) {
    static int grid_blocks = 0;
    if (grid_blocks == 0) {
        if (n_in != 17 || out_size != MTOK * 1024 || ws_size < 256 * MiB) { fprintf(stderr, "kernel_launch: unexpected problem shape (n_in %d out %d ws %zu)\n", n_in, out_size, ws_size); grid_blocks = -1; return; }
        int dev = 0, cus = 0, per_cu = 0;
        hipGetDevice(&dev);
        hipDeviceGetAttribute(&cus, hipDeviceAttributeMultiprocessorCount, dev);
        if (hipFuncSetAttribute((const void*)yoco_fwd, hipFuncAttributeMaxDynamicSharedMemorySize, LDS_BYTES) != hipSuccess) { fprintf(stderr, "kernel_launch: hipFuncSetAttribute failed\n"); grid_blocks = -1; return; }
        hipOccupancyMaxActiveBlocksPerMultiprocessor(&per_cu, (const void*)yoco_fwd, 512, LDS_BYTES);
        if (per_cu < 1) { fprintf(stderr, "kernel_launch: occupancy query says %d blocks per CU\n", per_cu); per_cu = 1; }
        grid_blocks = cus * 1;
    }
    if (grid_blocks < 0) return;
    if (hipMemsetAsync((char*)d_ws + WS_BAR, 0, XCD_BAR_WORDS * 4, stream) != hipSuccess) { fprintf(stderr, "kernel_launch: memset of barrier words failed\n"); return; }
    Params p{};
    for (int i = 0; i < 17; ++i) p.in[i] = (const float*)d_in[i];
    p.out = (float*)d_out; p.ws = (unsigned char*)d_ws;
    void* args[] = {&p};
    hipError_t e = hipLaunchCooperativeKernel((const void*)yoco_fwd, dim3(grid_blocks), dim3(512), args, LDS_BYTES, stream);
    if (e != hipSuccess) fprintf(stderr, "cooperative launch failed: %s (grid %d)\n", hipGetErrorString(e), grid_blocks);
}
```
